# Optimizing an MI355X kernel written in HIP

```python
import math
import jax, jax.numpy as jnp
from jax import lax
import numpy as np

D_MODEL = 1024
BATCH = 32
SEQ = 256
DEPTH = 2
DEC_BATCH = 8
DEC_SEQ = 1024
PAST_LEN = 512

GRID_W = 64
D_FF = 2816
S5_WIDTH = 512
S5_GROUP = 16
S5_GROUPS = S5_WIDTH // S5_GROUP
S5_STATE = 64
CONV_WIDTH = 256
CONV_K = 31
SG_WIDTH = 256
SG_CHUNK = 128
SG_HEADS = 4
SG_HEAD_DIM = SG_WIDTH // SG_HEADS
N_BRANCH = 3
IN_COLS = S5_WIDTH + 2 * CONV_WIDTH + 2 * SG_WIDTH
N_MOD = 9
EPS = 1e-6

kernel_name = 'hybrid_s5_conv_sgmlp_diffusion_step'


def _rmsnorm(x, g):
    xf = x.astype(jnp.float32)
    y = xf * lax.rsqrt(jnp.mean(xf * xf, axis=-1, keepdims=True) + EPS)
    return (y * g.astype(jnp.float32)).astype(x.dtype)


def _layernorm(x, g, b):
    xf = x.astype(jnp.float32)
    mu = jnp.mean(xf, axis=-1, keepdims=True)
    var = jnp.mean(jnp.square(xf - mu), axis=-1, keepdims=True)
    y = (xf - mu) * lax.rsqrt(var + EPS)
    return (y * g.astype(jnp.float32) + b.astype(jnp.float32)).astype(x.dtype)


def _swiglu(h, w1, w2):
    g, u = jnp.split(h @ w1, 2, axis=-1)
    return (jax.nn.silu(g) * u) @ w2


def _cmul(ar, ai, br, bi):
    return ar * br - ai * bi, ar * bi + ai * br


def _ssm_combine(e1, e2):
    a1r, a1i, b1r, b1i = e1
    a2r, a2i, b2r, b2i = e2
    ar, ai = _cmul(a2r, a2i, a1r, a1i)
    br, bi = _cmul(a2r, a2i, b1r, b1i)
    return ar, ai, br + b2r, bi + b2i


def _s5_direction(u, a_re, a_im, log_dt, b_re, b_im, c_re, c_im, h0, reverse):
    f32 = jnp.float32
    a_re = a_re.astype(f32); a_im = a_im.astype(f32)
    b_re = b_re.astype(f32); b_im = b_im.astype(f32)
    c_re = c_re.astype(f32); c_im = c_im.astype(f32)
    dt = jnp.exp(log_dt.astype(f32))[:, None]
    mag = jnp.exp(a_re * dt)
    abar_r, abar_i = mag * jnp.cos(a_im * dt), mag * jnp.sin(a_im * dt)
    den = a_re * a_re + a_im * a_im
    nr, ni = abar_r - 1.0, abar_i
    qr = (nr * a_re + ni * a_im) / den
    qi = (ni * a_re - nr * a_im) / den
    bbar_r = qr[..., None] * b_re - qi[..., None] * b_im
    bbar_i = qr[..., None] * b_im + qi[..., None] * b_re
    bu_r = jnp.einsum('gph,blgh->blgp', bbar_r, u)
    bu_i = jnp.einsum('gph,blgh->blgp', bbar_i, u)
    first = -1 if reverse else 0
    ir, ii = _cmul(abar_r, abar_i, h0[..., 0].astype(f32), h0[..., 1].astype(f32))
    bu_r = bu_r.at[:, first].add(ir)
    bu_i = bu_i.at[:, first].add(ii)
    ar = jnp.broadcast_to(abar_r, bu_r.shape)
    ai = jnp.broadcast_to(abar_i, bu_i.shape)
    _, _, sr, si = lax.associative_scan(_ssm_combine, (ar, ai, bu_r, bu_i), reverse=reverse, axis=1)
    y = jnp.einsum('ghp,blgp->blgh', c_re, sr) - jnp.einsum('ghp,blgp->blgh', c_im, si)
    last = 0 if reverse else -1
    h_final = jnp.stack([sr[:, last], si[:, last]], axis=-1)
    return y, h_final


def _s5_branch(z, P, l, h0):
    bn, L, _ = z.shape
    zf = z.astype(jnp.float32)
    u = zf.reshape(bn, L, S5_GROUPS, S5_GROUP)
    ys, hs = [], []
    for d, rev in ((0, False), (1, True)):
        y, hT = _s5_direction(u, P['s5_a_re'][l, d], P['s5_a_im'][l, d], P['s5_log_dt'][l, d],
                              P['s5_b_re'][l, d], P['s5_b_im'][l, d],
                              P['s5_c_re'][l, d], P['s5_c_im'][l, d], h0[:, d], rev)
        ys.append(y)
        hs.append(hT)
    y = (ys[0] + ys[1]).reshape(bn, L, S5_WIDTH) + P['s5_d'][l].astype(jnp.float32) * zf
    y = jax.nn.gelu(y)
    y = y * jax.nn.sigmoid(y @ P['s5_w_glu'][l].astype(jnp.float32))
    return y.astype(z.dtype), jnp.stack(hs, axis=1)


def _conv_branch(z, P, l):
    a, b = jnp.split(z, 2, axis=-1)
    g = a * jax.nn.sigmoid(b)
    w = P['conv_w'][l].astype(g.dtype)[:, None, :]
    y = lax.conv_general_dilated(g, w, window_strides=(1,), padding=[(CONV_K // 2, CONV_K // 2)],
                                 dimension_numbers=('NWC', 'WIO', 'NWC'),
                                 feature_group_count=CONV_WIDTH)
    y = y + P['conv_b'][l]
    y = _layernorm(y, P['conv_ln_g'][l], P['conv_ln_b'][l])
    return jax.nn.silu(y)


def _sgmlp_branch(z, P, l):
    bn, L, _ = z.shape
    z = jax.nn.gelu(z)
    u, v = jnp.split(z, 2, axis=-1)
    v = _layernorm(v, P['sg_ln_g'][l], P['sg_ln_b'][l])
    v = v.reshape(bn, L // SG_CHUNK, SG_CHUNK, SG_HEADS, SG_HEAD_DIM)
    s = jnp.einsum('hqk,bnkhc->bnqhc', P['sg_w'][l], v) + P['sg_b'][l].T[None, None, :, :, None]
    return u * s.reshape(bn, L, SG_WIDTH)


def _mixer(h, P, l, h0):
    z = h @ P['w_in'][l]
    z_a, z_b, z_c = jnp.split(z, [S5_WIDTH, S5_WIDTH + 2 * CONV_WIDTH], axis=-1)
    y_a, h_final = _s5_branch(z_a, P, l, h0)
    y_b = _conv_branch(z_b, P, l)
    y_c = _sgmlp_branch(z_c, P, l)
    gates = jax.nn.sigmoid(h @ P['w_gate'][l] + P['b_gate'][l])
    g_a, g_b, g_c = jnp.split(gates, N_BRANCH, axis=-1)
    merged = (g_a * (y_a @ P['w_br_a'][l]) + g_b * (y_b @ P['w_br_b'][l])
              + g_c * (y_c @ P['w_br_c'][l]))
    return merged @ P['w_out'][l], h_final


def _layer(x, cond, P, l, h0):
    mod = (jax.nn.silu(cond) @ P['w_mod'][l] + P['b_mod'][l]).reshape(cond.shape[0], N_MOD, 1, D_MODEL)
    sh1, sc1, gt1, sh2, sc2, gt2, sh3, sc3, gt3 = [mod[:, i] for i in range(N_MOD)]
    h = _rmsnorm(x, P['norm_g'][l, 0]) * (1.0 + sc1) + sh1
    x = x + 0.5 * gt1 * _swiglu(h, P['ffn_w1'][l, 0], P['ffn_w2'][l, 0])
    h = _rmsnorm(x, P['norm_g'][l, 1]) * (1.0 + sc2) + sh2
    y, h_final = _mixer(h, P, l, h0)
    x = x + gt2 * y
    h = _rmsnorm(x, P['norm_g'][l, 2]) * (1.0 + sc3) + sh3
    x = x + 0.5 * gt3 * _swiglu(h, P['ffn_w1'][l, 1], P['ffn_w2'][l, 1])
    return x, h_final


def _grid_pos_embed(n_tokens, dim):
    rows = n_tokens // GRID_W
    rr, cc = jnp.meshgrid(jnp.arange(rows, dtype=jnp.float32), jnp.arange(GRID_W, dtype=jnp.float32), indexing='ij')
    quarter = dim // 4
    omega = 1.0 / (10000.0 ** (jnp.arange(quarter, dtype=jnp.float32) / quarter))
    def emb(p):
        ang = p.reshape(-1)[:, None] * omega[None, :]
        return jnp.concatenate([jnp.sin(ang), jnp.cos(ang)], axis=-1)
    return jnp.concatenate([emb(rr), emb(cc)], axis=-1)


def setup_inputs(seed: int = 0) -> dict:
    key = jax.random.key(seed)
    ks = jax.random.split(key, 40)
    f32 = jnp.float32
    def nrm(k, shape, s):
        return jax.random.normal(k, shape, f32) * s
    n_idx = jnp.arange(S5_STATE, dtype=f32)
    s5a = (DEPTH, 2, S5_GROUPS, S5_STATE)
    s5b = (DEPTH, 2, S5_GROUPS, S5_STATE, S5_GROUP)
    s5c = (DEPTH, 2, S5_GROUPS, S5_GROUP, S5_STATE)
    return {
        'x_prompt': nrm(ks[0], (BATCH, SEQ, D_MODEL), 1.0),
        'x_sample': nrm(ks[1], (DEC_BATCH, DEC_SEQ, D_MODEL), 1.0),
        'state_ssm': nrm(ks[2], (DEC_BATCH, DEPTH, 2, S5_GROUPS, S5_STATE, 2), 0.1),
        'c': nrm(ks[3], (DEC_BATCH, D_MODEL), 1.0),
        'c_ctx': nrm(ks[4], (D_MODEL,), 1.0),
        'w_mod': nrm(ks[5], (DEPTH, D_MODEL, N_MOD * D_MODEL), 0.5 * D_MODEL ** -0.5),
        'b_mod': nrm(ks[6], (DEPTH, N_MOD * D_MODEL), 0.02),
        'norm_g': 1.0 + nrm(ks[7], (DEPTH, 3, D_MODEL), 0.02),
        'ffn_w1': nrm(ks[8], (DEPTH, 2, D_MODEL, 2 * D_FF), D_MODEL ** -0.5),
        'ffn_w2': nrm(ks[9], (DEPTH, 2, D_FF, D_MODEL), D_FF ** -0.5),
        'w_in': nrm(ks[10], (DEPTH, D_MODEL, IN_COLS), D_MODEL ** -0.5),
        'w_gate': nrm(ks[11], (DEPTH, D_MODEL, N_BRANCH * D_MODEL), D_MODEL ** -0.5),
        'b_gate': nrm(ks[12], (DEPTH, N_BRANCH * D_MODEL), 0.02),
        's5_a_re': -0.5 + nrm(ks[13], s5a, 0.01),
        's5_a_im': math.pi * n_idx + nrm(ks[14], s5a, 0.01),
        's5_log_dt': jax.random.uniform(ks[15], (DEPTH, 2, S5_GROUPS), f32, math.log(1e-3), math.log(1e-1)),
        's5_b_re': nrm(ks[16], s5b, (2 * S5_GROUP) ** -0.5),
        's5_b_im': nrm(ks[17], s5b, (2 * S5_GROUP) ** -0.5),
        's5_c_re': nrm(ks[18], s5c, S5_STATE ** -0.5),
        's5_c_im': nrm(ks[19], s5c, S5_STATE ** -0.5),
        's5_d': nrm(ks[20], (DEPTH, S5_WIDTH), 1.0),
        's5_w_glu': nrm(ks[21], (DEPTH, S5_WIDTH, S5_WIDTH), S5_WIDTH ** -0.5),
        'w_br_a': nrm(ks[22], (DEPTH, S5_WIDTH, D_MODEL), S5_WIDTH ** -0.5),
        'conv_w': nrm(ks[23], (DEPTH, CONV_K, CONV_WIDTH), CONV_K ** -0.5),
        'conv_b': nrm(ks[24], (DEPTH, CONV_WIDTH), 0.02),
        'conv_ln_g': 1.0 + nrm(ks[25], (DEPTH, CONV_WIDTH), 0.02),
        'conv_ln_b': nrm(ks[26], (DEPTH, CONV_WIDTH), 0.02),
        'w_br_b': nrm(ks[27], (DEPTH, CONV_WIDTH, D_MODEL), CONV_WIDTH ** -0.5),
        'sg_ln_g': 1.0 + nrm(ks[28], (DEPTH, SG_WIDTH), 0.02),
        'sg_ln_b': nrm(ks[29], (DEPTH, SG_WIDTH), 0.02),
        'sg_w': nrm(ks[30], (DEPTH, SG_HEADS, SG_CHUNK, SG_CHUNK), SG_CHUNK ** -0.5),
        'sg_b': 1.0 + nrm(ks[31], (DEPTH, SG_HEADS, SG_CHUNK), 0.02),
        'w_br_c': nrm(ks[32], (DEPTH, SG_WIDTH, D_MODEL), SG_WIDTH ** -0.5),
        'w_out': nrm(ks[33], (DEPTH, D_MODEL, D_MODEL), D_MODEL ** -0.5),
        'final_g': 1.0 + nrm(ks[34], (D_MODEL,), 0.02),
    }


def reference(x_prompt, x_sample, state_ssm, c, c_ctx, w_mod, b_mod, norm_g, ffn_w1, ffn_w2,
              w_in, w_gate, b_gate, s5_a_re, s5_a_im, s5_log_dt, s5_b_re, s5_b_im, s5_c_re, s5_c_im,
              s5_d, s5_w_glu, w_br_a, conv_w, conv_b, conv_ln_g, conv_ln_b, w_br_b,
              sg_ln_g, sg_ln_b, sg_w, sg_b, w_br_c, w_out, final_g):
    P = dict(w_mod=w_mod, b_mod=b_mod, norm_g=norm_g, ffn_w1=ffn_w1, ffn_w2=ffn_w2,
             w_in=w_in, w_gate=w_gate, b_gate=b_gate, s5_a_re=s5_a_re, s5_a_im=s5_a_im,
             s5_log_dt=s5_log_dt, s5_b_re=s5_b_re, s5_b_im=s5_b_im, s5_c_re=s5_c_re, s5_c_im=s5_c_im,
             s5_d=s5_d, s5_w_glu=s5_w_glu, w_br_a=w_br_a, conv_w=conv_w, conv_b=conv_b,
             conv_ln_g=conv_ln_g, conv_ln_b=conv_ln_b, w_br_b=w_br_b, sg_ln_g=sg_ln_g,
             sg_ln_b=sg_ln_b, sg_w=sg_w, sg_b=sg_b, w_br_c=w_br_c, w_out=w_out)
    xc = x_prompt
    h_zero = jnp.zeros((x_prompt.shape[0], 2, S5_GROUPS, S5_STATE, 2), jnp.float32)
    ctx_states = []
    for l in range(DEPTH):
        xc, h_final = _layer(xc, c_ctx[None, :], P, l, h_zero)
        ctx_states.append(h_final)
    y_prompt = _rmsnorm(xc, final_g)
    new_state_ssm = jnp.stack(ctx_states, axis=1)
    xs = x_sample + _grid_pos_embed(x_sample.shape[1], D_MODEL).astype(x_sample.dtype)[None]
    for l in range(DEPTH):
        xs, _ = _layer(xs, c, P, l, state_ssm[:, l])
    y_sample = _rmsnorm(xs, final_g)
    return (y_prompt, y_sample, new_state_ssm)
```

```cpp
#include <hip/hip_runtime.h>
#include <cstdio>
#include <cstdint>

#define LAS __attribute__((address_space(3)))
#define GAS __attribute__((address_space(1)))
typedef unsigned short bf16_t;
typedef short bf16x8 __attribute__((ext_vector_type(8)));
typedef float f32x4 __attribute__((ext_vector_type(4)));
typedef float f32x2 __attribute__((ext_vector_type(2)));
typedef float f32x16 __attribute__((ext_vector_type(16)));
typedef unsigned u32x4 __attribute__((ext_vector_type(4)));
typedef unsigned u32x2 __attribute__((ext_vector_type(2)));
typedef __bf16 bf16x2_t __attribute__((ext_vector_type(2)));
typedef GAS unsigned gu32;

#ifndef MK_PER_PHASE
#define MK_PER_PHASE 0
#endif
#ifndef REP_MASK
#define REP_MASK 0
#endif
#ifndef REP_BAR
#define REP_BAR 0
#endif
#ifndef REP0_PARTS
#define REP0_PARTS 15
#endif
#ifndef REP5_PARTS
#define REP5_PARTS 7
#endif

constexpr int D = 1024, MCTX = 8192, MSMP = 8192, M = 16384, CTXL = 256, SMPL = 1024, NCTXB = 32, NSMPB = 8, DEPTH = 2;
constexpr int DFF = 2816, S5W = 512, NG = 32, GH = 16, NP = 64, CW = 256, CK = 31, SGW = 256, SGC = 128, SGH = 4, SGD = 64, INC = 1536, NMOD = 9;
constexpr int NIN = 4608;
constexpr int TC = 16;
constexpr int YR = M / TC;
constexpr float EPS = 1e-6f;
constexpr int NWAVES = 8;

constexpr size_t MiB = 1u << 20;
constexpr size_t WS_CTL = 0, CTL_ZERO_BYTES = 3 * MiB;
constexpr size_t WS_MOD = 1 * MiB;
constexpr size_t WS_SSQ = 2 * MiB;
constexpr size_t WS_PE = 3 * MiB;
constexpr size_t WS_AT = 3 * MiB + 256 * 1024;
constexpr size_t WS_SHW = 4 * MiB;
constexpr int SHW_LD = 5632;
constexpr size_t WS_W = 6 * MiB;
constexpr size_t W1T_SZ = (size_t)2 * DFF * D * 2, W2T_SZ = (size_t)D * DFF * 2, WINT_SZ = (size_t)NIN * D * 2, WGLUT_SZ = (size_t)S5W * S5W * 2, WBRT_SZ = (size_t)D * D * 2, WOUTT_SZ = (size_t)D * D * 2;
constexpr size_t WL_W1 = 0, WL_W2 = 2 * W1T_SZ, WL_WIN = WL_W2 + 2 * W2T_SZ, WL_WGLU = WL_WIN + WINT_SZ, WL_WBR = WL_WGLU + WGLUT_SZ, WL_WOUT = WL_WBR + WBRT_SZ, WL_SZ = WL_WOUT + WOUTT_SZ;
static_assert(WL_SZ == (size_t)24379392 * 2, "weight bytes per layer");
constexpr size_t WS_KP = 100 * MiB;
constexpr size_t WS_PIN = 116 * MiB;
constexpr size_t WS_H = 124 * MiB;
constexpr size_t WS_HID = 156 * MiB;
constexpr size_t WS_YCAT = WS_HID;
constexpr size_t WS_CG = WS_HID + 32 * MiB;
constexpr size_t WS_SU = WS_HID + 40 * MiB;
constexpr size_t WS_SV = WS_HID + 48 * MiB;
constexpr size_t WS_YA = WS_HID + 56 * MiB;
constexpr size_t WS_SVST = WS_HID + 72 * MiB;
constexpr size_t WS_MG = WS_HID;
constexpr size_t WS_GATES = 244 * MiB;
constexpr size_t WS_END = 340 * MiB;
static_assert(WS_W + 2 * WL_SZ <= WS_KP && WS_HID + (size_t)M * DFF * 2 <= WS_GATES && WS_GATES + (size_t)M * 3 * D * 2 <= WS_END && WS_SHW + (size_t)6 * 9 * SHW_LD * 4 <= WS_W, "d_ws map");
constexpr int CW_TMO = 0, CW_BAR = 4096;

constexpr int RING_BYTES = 131072, LDSCTL_OFF = RING_BYTES, MISC_OFF = LDSCTL_OFF + 320, LDS_BYTES = 147456;
constexpr int STASH_OFF = RING_BYTES + 512, STASH_UNITS = 6;
static_assert(STASH_OFF + STASH_UNITS * 2048 <= LDS_BYTES, "LDS map");

#define RLX_AGENT __ATOMIC_RELAXED, __HIP_MEMORY_SCOPE_AGENT
#define LDS_WAIT() asm volatile("s_waitcnt lgkmcnt(0)" ::: "memory")
#define VM_WAIT() asm volatile("s_waitcnt vmcnt(0)" ::: "memory")
#ifndef WT_STORES
#define WT_STORES 0
#endif
__device__ __forceinline__ void st16(void* p, u32x4 v) {
#if WT_STORES
    asm volatile("global_store_dwordx4 %0, %1, off sc1\n\ts_nop 1" :: "v"(p), "v"(v) : "memory");
#else
    *(u32x4*)p = v;
#endif
}
__device__ __forceinline__ void st16f(void* p, f32x4 v) { st16(p, __builtin_bit_cast(u32x4, v)); }
__device__ __forceinline__ unsigned pk2(float lo, float hi) { f32x2 v = {lo, hi}; bf16x2_t b = __builtin_convertvector(v, bf16x2_t); return __builtin_bit_cast(unsigned, b); }
__device__ __forceinline__ float bflo(unsigned w) { return __uint_as_float(w << 16); }
__device__ __forceinline__ float bfhi(unsigned w) { return __uint_as_float(w & 0xffff0000u); }
__device__ __forceinline__ float bf1(bf16_t b) { return __uint_as_float((unsigned)b << 16); }
__device__ __forceinline__ float fast_sigmoid(float x) { return __builtin_amdgcn_rcpf(1.f + __expf(-x)); }
__device__ __forceinline__ float fast_silu(float x) { return x * fast_sigmoid(x); }
__device__ __forceinline__ float fast_gelu(float x) { const float u = 1.5957691216057308f * (x + 0.044715f * x * x * x); return x * fast_sigmoid(u); }
__device__ __forceinline__ float wave_sum(float v) {
#pragma unroll
    for (int o = 1; o < 64; o <<= 1) v += __shfl_xor(v, o);
    return v;
}
__device__ __forceinline__ int lane_id() { return (int)__builtin_amdgcn_mbcnt_hi(~0u, __builtin_amdgcn_mbcnt_lo(~0u, 0u)); }
__device__ __forceinline__ int tid_of(int wv) { return wv * 64 + lane_id(); }
__device__ __forceinline__ int cond_of_row(int row) { return row < MCTX ? 0 : 1 + ((row - MCTX) >> 10); }
__device__ __forceinline__ int cond_of_tile(int pm) { return pm < 32 ? 0 : 1 + ((pm - 32) >> 2); }

namespace pg8 {
constexpr int BM = 256, BK = 64, HALF = 128, HTB = HALF * BK * 2, NXCD = 8, WGM = 8;
__host__ __device__ __forceinline__ int lds_byte(int r, int c) { const int st = (r >> 4) * 2 + (c >> 5), rr = r & 15, cc = c & 31, ob = rr * 64 + cc * 2; return st * 1024 + (ob ^ (((ob >> 9) & 1) << 5)); }
__host__ __device__ __forceinline__ void stage_rc(int b, int& R, int& C) { const int st = b / 1024, sb = b % 1024, swz = sb ^ (((sb >> 9) & 1) << 5); R = (st >> 1) * 16 + swz / 64; C = (st & 1) * 32 + (swz % 64) / 2; }
__host__ __device__ __forceinline__ int perm32(int rho) { const int n = rho >> 4, i = rho & 15; return 8 * (i >> 2) + 4 * n + (i & 3); }

struct Unit { int pm, pn, nt, seg, idx; const char* a; const char* b; };
struct TileOrder {
    int nM, nN, nwg, G, c;
    __device__ __forceinline__ void init(int nM_, int nN_, int G_, int c_) { nM = nM_; nN = nN_; nwg = nM * nN; G = G_; c = c_; }
    __device__ __forceinline__ bool tile(int i, int& pm, int& pn) const {
        const long L = (long)i * G + c; if (L >= nwg) return false;
        int wgid = (int)L; { const int q = nwg / NXCD, r = nwg % NXCD, xcd = wgid % NXCD, off = wgid / NXCD; wgid = (xcd < r ? xcd * (q + 1) : r * (q + 1) + (xcd - r) * q) + off; }
        const int nig = WGM * nN, gid = wgid / nig, fm = gid * WGM, gsz = (nM - fm) < WGM ? (nM - fm) : WGM;
        pm = fm + ((wgid % nig) % gsz); pn = (wgid % nig) / gsz; return true;
    }
};
struct PlainSched {
    TileOrder T; const char* A; const char* Bt; long aStride, bStride, bgStride; int bgShift, nt;
    __device__ __forceinline__ bool next(int i, Unit& u) const {
        if (!T.tile(i, u.pm, u.pn)) return false;
        u.a = A + (long)u.pm * aStride; u.b = Bt + (long)u.pn * bStride + (long)(u.pm >> bgShift) * bgStride; u.nt = nt; u.seg = 0; return true; }
};
struct Seg3Sched {
    TileOrder T; const char* A; const char* Bt; long aStride, bStride;
    __device__ __forceinline__ bool next(int i, Unit& u) const {
        const int ti = i / 3, sg = i - 3 * ti;
        if (!T.tile(ti, u.pm, u.pn)) return false;
        const int koff = sg == 0 ? 0 : (sg == 1 ? 512 : 768);
        u.a = A + (long)u.pm * aStride + koff * 2; u.b = Bt + (long)u.pn * bStride + koff * 2; u.nt = sg == 0 ? 8 : 4; u.seg = sg; return true; }
};

typedef f32x4 Acc[2][2][4][2];

template <class Epi, class Sched, bool ALIGN_EPI, bool SP2>
__device__ __forceinline__ void gemm_phase(LAS unsigned char* lds, const int lda, const int ldb, const Sched& S, const Epi& E, const int wv) {
    int tid = tid_of(wv); asm volatile("" : "+v"(tid));
    const int wid = wv, lane = tid & 63, wr = wid >> 2, wc = wid & 3, fr = lane & 15, fq = lane >> 4;
    unsigned voffA[2], voffB[2];
#pragma unroll
    for (int i = 0; i < 2; ++i) { int R, C; stage_rc(tid * 16 + i * 8192, R, C); const int Rb = Epi::PERM ? ((R & ~31) + perm32(R & 31)) : R;
        voffA[i] = (unsigned)(R * lda + C) * 2u; voffB[i] = (unsigned)(Rb * ldb + C) * 2u; }
    const size_t kstep = (size_t)(BK * 2);
    const size_t hstepA = (size_t)HALF * lda * 2, hstepB = (size_t)HALF * ldb * 2;
    const unsigned ldsw = (unsigned)wid * 1024u;
    const int aoff = lds_byte(wr * 64 + fr, fq * 8), boff = lds_byte(wc * 32 + fr, fq * 8);
#define PG8_SA(b, h) (((b) * 2 + (h)) * HTB)
#define PG8_SB(b, h) ((4 + (b) * 2 + (h)) * HTB)
#define PG8_STAGE(bufoff, gbase, voff) do { _Pragma("unroll") for (int _i = 0; _i < 2; ++_i) \
        __builtin_amdgcn_global_load_lds((const unsigned*)((const char*)(gbase) + (voff)[_i]), (LAS unsigned*)(lds + (bufoff) + ldsw + _i * 8192), 16, 0, 0); } while (0)
#define PG8_LDA(dst, b, h) do { _Pragma("unroll") for (int m = 0; m < 4; ++m) _Pragma("unroll") for (int k = 0; k < 2; ++k) dst[m][k] = *(const LAS bf16x8*)(lds + PG8_SA(b, h) + aoff + m * 2048 + k * 1024); } while (0)
#define PG8_LDB(dst, b, h) do { _Pragma("unroll") for (int n = 0; n < 2; ++n) _Pragma("unroll") for (int k = 0; k < 2; ++k) dst[n][k] = *(const LAS bf16x8*)(lds + PG8_SB(b, h) + boff + n * 2048 + k * 1024); } while (0)
#define PG8_MMA(ai, bj, At, Bt) do { __builtin_amdgcn_s_setprio(1); _Pragma("unroll") for (int m = 0; m < 4; ++m) _Pragma("unroll") for (int n = 0; n < 2; ++n) _Pragma("unroll") for (int k = 0; k < 2; ++k) \
        acc[ai][bj][m][n] = __builtin_amdgcn_mfma_f32_16x16x32_bf16(Bt[n][k], At[m][k], acc[ai][bj][m][n], 0, 0, 0); __builtin_amdgcn_s_setprio(0); } while (0)
#define PG8_WAIT_V(n) asm volatile("s_waitcnt vmcnt(" #n ")" ::: "memory")
#define PG8_WAIT_L(n) asm volatile("s_waitcnt lgkmcnt(" #n ")" ::: "memory")
#define PG8_BAR __builtin_amdgcn_s_barrier()
#define PG8_SCHED __builtin_amdgcn_sched_barrier(0)
    Unit cur, nxt; int ui = 0;
    if (!S.next(0, cur)) return;
    cur.idx = 0;
    Acc acc;
#pragma unroll
    for (int a = 0; a < 2; ++a)
#pragma unroll
        for (int b = 0; b < 2; ++b)
#pragma unroll
            for (int m = 0; m < 4; ++m)
#pragma unroll
                for (int n = 0; n < 2; ++n) acc[a][b][m][n] = (f32x4){0.f, 0.f, 0.f, 0.f};
    bf16x8 At[4][2], B0[2][2], B1[2][2];
    const char* cA = cur.a; const char* cB = cur.b;
    if constexpr (SP2) {
        PG8_STAGE(PG8_SB(0, 0), cB, voffB); PG8_STAGE(PG8_SB(0, 1), cB + hstepB, voffB); PG8_STAGE(PG8_SA(0, 0), cA, voffA); PG8_STAGE(PG8_SA(0, 1), cA + hstepA, voffA);
        if (wr == 1) PG8_BAR;
        PG8_WAIT_V(2); PG8_BAR;
        PG8_STAGE(PG8_SB(1, 0), cB + kstep, voffB); PG8_STAGE(PG8_SA(1, 0), cA + kstep, voffA); PG8_STAGE(PG8_SB(1, 1), cB + hstepB + kstep, voffB);
        PG8_WAIT_V(6); PG8_BAR;
    } else {
        PG8_STAGE(PG8_SB(0, 0), cB, voffB); PG8_STAGE(PG8_SA(0, 0), cA, voffA); PG8_STAGE(PG8_SB(0, 1), cB + hstepB, voffB); PG8_STAGE(PG8_SA(0, 1), cA + hstepA, voffA);
        if (wr == 1) PG8_BAR;
        PG8_WAIT_V(4); PG8_BAR;
        PG8_STAGE(PG8_SB(1, 0), cB + kstep, voffB); PG8_STAGE(PG8_SA(1, 0), cA + kstep, voffA); PG8_STAGE(PG8_SB(1, 1), cB + hstepB + kstep, voffB);
        PG8_WAIT_V(6); PG8_BAR;
    }
    for (;;) {
        const bool has_next = S.next(ui + 1, nxt); nxt.idx = ui + 1;
        const char* nA = has_next ? nxt.a : cA; const char* nB = has_next ? nxt.b : cB;
        const int nt = cur.nt;
        for (int t = 0; t < nt; t += 2) {
            const bool last = (t == nt - 2);
            const char* a1 = cA + (size_t)(t + 1) * kstep;
            const char* a2 = last ? nA : cA + (size_t)(t + 2) * kstep; const char* b2 = last ? nB : cB + (size_t)(t + 2) * kstep;
            const char* a3 = a2 + kstep; const char* b3 = b2 + kstep;
            if constexpr (SP2) {
            PG8_LDB(B0, 0, 0); PG8_LDB(B1, 0, 1); PG8_SCHED; PG8_LDA(At, 0, 0); PG8_STAGE(PG8_SA(1, 1), a1 + hstepA, voffA);
            PG8_WAIT_V(8); PG8_WAIT_L(0); PG8_BAR; PG8_MMA(0, 0, At, B0); PG8_MMA(0, 1, At, B1); PG8_BAR; PG8_SCHED;
            PG8_LDA(At, 0, 1); PG8_STAGE(PG8_SB(0, 0), b2, voffB); PG8_STAGE(PG8_SB(0, 1), b2 + hstepB, voffB); PG8_STAGE(PG8_SA(0, 0), a2, voffA);
            PG8_WAIT_V(8); PG8_WAIT_L(0); PG8_BAR; PG8_MMA(1, 0, At, B0); PG8_MMA(1, 1, At, B1); PG8_BAR; PG8_SCHED;
            PG8_LDB(B0, 1, 0); PG8_LDB(B1, 1, 1); PG8_SCHED; PG8_LDA(At, 1, 0); PG8_STAGE(PG8_SA(0, 1), a2 + hstepA, voffA);
            PG8_WAIT_V(8); PG8_WAIT_L(0); PG8_BAR; PG8_MMA(0, 0, At, B0); PG8_MMA(0, 1, At, B1); PG8_BAR; PG8_SCHED;
            PG8_LDA(At, 1, 1); PG8_STAGE(PG8_SB(1, 0), b3, voffB); PG8_STAGE(PG8_SB(1, 1), b3 + hstepB, voffB); PG8_STAGE(PG8_SA(1, 0), a3, voffA);
            PG8_WAIT_V(8); PG8_WAIT_L(0); PG8_BAR; PG8_MMA(1, 0, At, B0); PG8_MMA(1, 1, At, B1); PG8_BAR; PG8_SCHED;
            } else {
            PG8_LDB(B0, 0, 0); PG8_SCHED; PG8_LDA(At, 0, 0); PG8_STAGE(PG8_SA(1, 1), a1 + hstepA, voffA);
            PG8_WAIT_L(8); PG8_BAR; PG8_WAIT_L(0); PG8_MMA(0, 0, At, B0); PG8_BAR; PG8_SCHED;
            PG8_LDB(B1, 0, 1); PG8_STAGE(PG8_SB(0, 0), b2, voffB);
            PG8_BAR; PG8_WAIT_L(0); PG8_MMA(0, 1, At, B1); PG8_BAR;
            PG8_LDA(At, 0, 1); PG8_STAGE(PG8_SA(0, 0), a2, voffA);
            PG8_BAR; PG8_WAIT_L(0); PG8_MMA(1, 0, At, B0); PG8_BAR; PG8_SCHED;
            PG8_STAGE(PG8_SB(0, 1), b2 + hstepB, voffB);
            PG8_WAIT_V(6); PG8_BAR; PG8_MMA(1, 1, At, B1); PG8_BAR;
            PG8_LDB(B0, 1, 0); PG8_SCHED; PG8_LDA(At, 1, 0); PG8_STAGE(PG8_SA(0, 1), a2 + hstepA, voffA);
            PG8_WAIT_L(8); PG8_BAR; PG8_WAIT_L(0); PG8_MMA(0, 0, At, B0); PG8_BAR; PG8_SCHED;
            PG8_LDB(B1, 1, 1); PG8_STAGE(PG8_SB(1, 0), b3, voffB);
            PG8_BAR; PG8_WAIT_L(0); PG8_MMA(0, 1, At, B1); PG8_BAR;
            PG8_LDA(At, 1, 1); PG8_STAGE(PG8_SA(1, 0), a3, voffA);
            PG8_BAR; PG8_WAIT_L(0); PG8_MMA(1, 0, At, B0); PG8_BAR; PG8_SCHED;
            PG8_STAGE(PG8_SB(1, 1), b3 + hstepB, voffB);
            PG8_WAIT_V(6); PG8_BAR; PG8_MMA(1, 1, At, B1); PG8_BAR;
            }
        }
        if constexpr (ALIGN_EPI) { if (wr == 0) PG8_BAR; }
        bool keep = false;
        if constexpr (!Epi::AFTER_DRAIN) { keep = E(acc, cur, wr, wc, fr, fq); }
        if (!has_next) break;
        if (!keep) {
#pragma unroll
        for (int a = 0; a < 2; ++a)
#pragma unroll
            for (int b = 0; b < 2; ++b)
#pragma unroll
                for (int m = 0; m < 4; ++m)
#pragma unroll
                    for (int n = 0; n < 2; ++n) acc[a][b][m][n] = (f32x4){0.f, 0.f, 0.f, 0.f};
        }
        cur = nxt; cA = nA; cB = nB; ++ui;
        if constexpr (ALIGN_EPI) { if (wr == 1) PG8_BAR; }
    }
    PG8_WAIT_V(0);
    if constexpr (!ALIGN_EPI) { if (wr == 0) PG8_BAR; }
    PG8_BAR;
    if constexpr (Epi::AFTER_DRAIN) { E.fused(acc, cur, wr, wc, fr, fq, lds, wid, lane); }
#undef PG8_SA
#undef PG8_SB
#undef PG8_STAGE
#undef PG8_LDA
#undef PG8_LDB
#undef PG8_MMA
#undef PG8_WAIT_V
#undef PG8_WAIT_L
#undef PG8_BAR
#undef PG8_SCHED
}

struct Stash { const LAS float* r; const LAS float* s; };
struct EpiSwiGLU {
    static constexpr bool PERM = true, AFTER_DRAIN = false;
    bf16_t* hid; Stash st;
    __device__ __forceinline__ bool operator()(Acc& acc, const Unit& u, int wr, int wc, int fr, int fq) const {
        const unsigned off0 = (unsigned)(u.pm * BM + wr * 64 + fr) * DFF + u.pn * 128 + wc * 32 + 8 * fq;
        const LAS float* sp = st.s + u.idx * 256 + wc * 32 + 8 * fq; const LAS float* rp = st.r + u.idx * 256 + wr * 64 + fr;
#pragma unroll
        for (int ai = 0; ai < 2; ++ai)
#pragma unroll
            for (int m = 0; m < 4; ++m) {
                const float r = rp[ai * HALF + m * 16];
                const f32x4 sg0 = *(const LAS f32x4*)(sp), sg1 = *(const LAS f32x4*)(sp + 4), su0 = *(const LAS f32x4*)(sp + 128), su1 = *(const LAS f32x4*)(sp + 132);
                const f32x4 g0 = acc[ai][0][m][0] * r + sg0, g1 = acc[ai][0][m][1] * r + sg1, u0 = acc[ai][1][m][0] * r + su0, u1 = acc[ai][1][m][1] * r + su1;
                u32x4 w;
                w.x = pk2(fast_silu(g0[0]) * u0[0], fast_silu(g0[1]) * u0[1]); w.y = pk2(fast_silu(g0[2]) * u0[2], fast_silu(g0[3]) * u0[3]);
                w.z = pk2(fast_silu(g1[0]) * u1[0], fast_silu(g1[1]) * u1[1]); w.w = pk2(fast_silu(g1[2]) * u1[2], fast_silu(g1[3]) * u1[3]);
                st16(hid + (off0 + (unsigned)(ai * HALF + m * 16) * DFF), w);
                asm volatile("" ::: "memory");
            }
        return false;
    }
};
struct EpiResid {
    static constexpr bool PERM = true, AFTER_DRAIN = false;
    float* X; const float* modl; int sub; float scale;
    bf16_t* xb; const float* gnext; const float* modn; int subn; float* ssq;
    __device__ __forceinline__ bool operator()(Acc& acc, const Unit& u, int wr, int wc, int fr, int fq) const {
        const unsigned row0 = u.pm * BM + wr * 64 + fr, col0 = u.pn * BM + wc * 32 + 8 * fq;
        const unsigned cond = cond_of_tile(u.pm);
        const unsigned goff = cond * (NMOD * D) + (3 * sub + 2) * D + col0, noff = cond * (NMOD * D) + (3 * subn + 1) * D + col0;
        const bool nx = xb != nullptr;
        float ss[8];
#pragma unroll
        for (int i = 0; i < 8; ++i) ss[i] = 0.f;
#pragma unroll
        for (int bj = 0; bj < 2; ++bj) {
            const f32x4 gv0 = *(const f32x4*)(modl + goff + bj * HALF) * scale, gv1 = *(const f32x4*)(modl + goff + bj * HALF + 4) * scale;
            f32x4 G0 = (f32x4){0.f, 0.f, 0.f, 0.f}, G1 = G0;
            if (nx) { G0 = *(const f32x4*)(gnext + col0 + bj * HALF) * (*(const f32x4*)(modn + noff + bj * HALF) + 1.f); G1 = *(const f32x4*)(gnext + col0 + bj * HALF + 4) * (*(const f32x4*)(modn + noff + bj * HALF + 4) + 1.f); }
#pragma unroll
            for (int ai = 0; ai < 2; ++ai)
#pragma unroll
                for (int m = 0; m < 4; ++m) {
                    const unsigned eoff = (row0 + ai * HALF + m * 16) * D + col0 + bj * HALF;
                    f32x4 x0 = *(const f32x4*)(X + eoff), x1 = *(const f32x4*)(X + eoff + 4);
                    x0 = x0 + gv0 * acc[ai][bj][m][0]; x1 = x1 + gv1 * acc[ai][bj][m][1];
                    st16f(X + eoff, x0); st16f(X + eoff + 4, x1);
                    if (nx) {
                        ss[ai * 4 + m] += ((x0[0] * x0[0] + x0[1] * x0[1]) + (x0[2] * x0[2] + x0[3] * x0[3])) + ((x1[0] * x1[0] + x1[1] * x1[1]) + (x1[2] * x1[2] + x1[3] * x1[3]));
                        const f32x4 b0 = x0 * G0, b1 = x1 * G1;
                        u32x4 w; w.x = pk2(b0[0], b0[1]); w.y = pk2(b0[2], b0[3]); w.z = pk2(b1[0], b1[1]); w.w = pk2(b1[2], b1[3]);
                        st16(xb + eoff, w); }
                    if (m & 1) asm volatile("" ::: "memory");
                }
        }
        if (nx) {
#pragma unroll
            for (int i = 0; i < 8; ++i) { float v = ss[i]; v += __shfl_xor(v, 16); v += __shfl_xor(v, 32); if (fq == 0) atomicAdd(ssq + row0 + (i >> 2) * HALF + (i & 3) * 16, v); }
        }
        return false;
    }
};
struct EpiMixIn {
    static constexpr bool PERM = true, AFTER_DRAIN = false;
    bf16_t* ycat; bf16_t* cg; bf16_t* su; bf16_t* sv; bf16_t* gates; float* svst; Stash st;
    __device__ __forceinline__ bool operator()(Acc& acc, const Unit& u, int wr, int wc, int fr, int fq) const {
        const int row0 = u.pm * BM + wr * 64 + fr;
        const int pn = u.pn;
        const LAS float* sp = st.s + u.idx * 256 + wc * 32 + 8 * fq; const LAS float* rp = st.r + u.idx * 256 + wr * 64 + fr;
#pragma unroll
        for (int ai = 0; ai < 2; ++ai)
#pragma unroll
            for (int m = 0; m < 4; ++m) {
                const float r = rp[ai * HALF + m * 16];
                const size_t row = row0 + ai * HALF + m * 16;
                f32x4 z[2][2];
#pragma unroll
                for (int bj = 0; bj < 2; ++bj)
#pragma unroll
                    for (int n = 0; n < 2; ++n) z[bj][n] = acc[ai][bj][m][n] * r + *(const LAS f32x4*)(sp + bj * 128 + 4 * n);
                if (pn < 2) {
#pragma unroll
                    for (int bj = 0; bj < 2; ++bj) {
                        const int g = 16 * pn + 8 * bj + 2 * wc + (fq >> 1), h0 = 8 * (fq & 1);
                        const int rr = 16 * u.pm + 8 * ai + 4 * wr + m;
                        u32x4 w; w.x = pk2(z[bj][0][0], z[bj][0][1]); w.y = pk2(z[bj][0][2], z[bj][0][3]); w.z = pk2(z[bj][1][0], z[bj][1][1]); w.w = pk2(z[bj][1][2], z[bj][1][3]);
                        st16(ycat + ((size_t)(g * YR + rr) * 512 + fr * 16 + h0), w);
                    }
                } else if (pn < 4) {
                    u32x4 w;
                    w.x = pk2(z[0][0][0] * fast_sigmoid(z[1][0][0]), z[0][0][1] * fast_sigmoid(z[1][0][1])); w.y = pk2(z[0][0][2] * fast_sigmoid(z[1][0][2]), z[0][0][3] * fast_sigmoid(z[1][0][3]));
                    w.z = pk2(z[0][1][0] * fast_sigmoid(z[1][1][0]), z[0][1][1] * fast_sigmoid(z[1][1][1])); w.w = pk2(z[0][1][2] * fast_sigmoid(z[1][1][2]), z[0][1][3] * fast_sigmoid(z[1][1][3]));
                    st16(cg + row * CW + (pn - 2) * 128 + wc * 32 + 8 * fq, w);
                } else if (pn < 6) {
                    bf16_t* dst = pn == 4 ? su : sv;
                    float s1 = 0.f, s2 = 0.f;
#pragma unroll
                    for (int bj = 0; bj < 2; ++bj) {
                        f32x4 g0, g1;
#pragma unroll
                        for (int e = 0; e < 4; ++e) { g0[e] = fast_gelu(z[bj][0][e]); g1[e] = fast_gelu(z[bj][1][e]); }
                        s1 += ((g0[0] + g0[1]) + (g0[2] + g0[3])) + ((g1[0] + g1[1]) + (g1[2] + g1[3]));
                        s2 += ((g0[0] * g0[0] + g0[1] * g0[1]) + (g0[2] * g0[2] + g0[3] * g0[3])) + ((g1[0] * g1[0] + g1[1] * g1[1]) + (g1[2] * g1[2] + g1[3] * g1[3]));
                        u32x4 w; w.x = pk2(g0[0], g0[1]); w.y = pk2(g0[2], g0[3]); w.z = pk2(g1[0], g1[1]); w.w = pk2(g1[2], g1[3]);
                        st16(dst + row * SGW + bj * HALF + wc * 32 + 8 * fq, w);
                    }
                    if (pn == 5) { s1 += __shfl_xor(s1, 16); s1 += __shfl_xor(s1, 32); s2 += __shfl_xor(s2, 16); s2 += __shfl_xor(s2, 32);
                        if (fq == 0) *(f32x2*)(svst + (row * 4 + wc) * 2) = (f32x2){s1, s2}; }
                } else {
#pragma unroll
                    for (int bj = 0; bj < 2; ++bj) {
                        u32x4 w; w.x = pk2(fast_sigmoid(z[bj][0][0]), fast_sigmoid(z[bj][0][1])); w.y = pk2(fast_sigmoid(z[bj][0][2]), fast_sigmoid(z[bj][0][3]));
                        w.z = pk2(fast_sigmoid(z[bj][1][0]), fast_sigmoid(z[bj][1][1])); w.w = pk2(fast_sigmoid(z[bj][1][2]), fast_sigmoid(z[bj][1][3]));
                        st16(gates + row * (3 * D) + (pn - 6) * BM + wc * 32 + 8 * fq + bj * HALF, w);
                    }
                }
            }
        return false;
    }
};
struct EpiS5X {
    static constexpr bool PERM = false, AFTER_DRAIN = true;
    bf16_t* ycat; const float* aT; const float* state_in; float* state_out; int l;
    __device__ __forceinline__ bool operator()(Acc&, const Unit&, int, int, int, int) const { return false; }
    __device__ __forceinline__ void fused(Acc& acc, const Unit& u, int wr, int wc, int fr, int fq, LAS unsigned char* lds, int wid, int lane) const {
        const int g = u.pm >> 2, quarter = u.pm & 3; const bool is_ctx = quarter < 2;
        LAS float* XS = (LAS float*)lds;
        const int p = lane;
#pragma unroll
        for (int dir = 0; dir < 2; ++dir) {
            __syncthreads();
#pragma unroll
            for (int ai = 0; ai < 2; ++ai)
#pragma unroll
                for (int m = 0; m < 4; ++m)
#pragma unroll
                    for (int n = 0; n < 2; ++n) { const int row = 128 * ai + 64 * wr + 16 * m + fr, col = 32 * wc + 16 * n + 4 * fq;
                        *(LAS f32x4*)(XS + row * 128 + (col ^ ((row & 7) << 2))) = acc[ai][dir][m][n]; }
            __syncthreads();
            const f32x2 at = *(const f32x2*)(aT + ((size_t)(dir * NG + g) * NP + p) * 2);
            int nseq, rows_per_seq, row_first; long bbase;
            if (is_ctx) { nseq = 2; rows_per_seq = 16; row_first = 32 * wid; bbase = quarter * 16 + 2 * wid; }
            else { nseq = wid < 4 ? 1 : 0; rows_per_seq = 64; row_first = 64 * wid; bbase = (quarter - 2) * 4 + wid; }
            for (int s = 0; s < nseq; ++s) {
                const long b = bbase + s;
                const size_t so = ((((size_t)b * DEPTH + l) * 2 + dir) * NG + g) * NP + p;
                float sr = 0.f, si = 0.f;
                if (!is_ctx) { const f32x2 h0 = *(const f32x2*)(state_in + so * 2); sr = h0.x; si = h0.y; }
                const int r0 = row_first + s * rows_per_seq;
                for (int q = 0; q < rows_per_seq; ++q) {
                    const int row = dir == 0 ? r0 + q : r0 + rows_per_seq - 1 - q;
                    const int sw = (row & 7) << 2;
                    const float xr = XS[row * 128 + (p ^ sw)], xi = XS[row * 128 + ((64 + p) ^ sw)];
                    bf16_t* dst = ycat + ((size_t)(g * YR + quarter * 256 + row) * 512 + 256 + dir * 128 + p);
                    const unsigned pr = pk2(sr, si);
                    dst[0] = (bf16_t)(pr & 0xffffu); dst[64] = (bf16_t)(pr >> 16);
                    const float nsr = at.x * sr - at.y * si + xr, nsi = at.x * si + at.y * sr + xi;
                    sr = nsr; si = nsi;
                }
                if (is_ctx) *(f32x2*)(state_out + so * 2) = (f32x2){sr, si};
            }
        }
    }
};
struct EpiS5Y {
    static constexpr bool PERM = true, AFTER_DRAIN = false;
    bf16_t* ya;
    __device__ __forceinline__ bool operator()(Acc& acc, const Unit& u, int wr, int wc, int fr, int fq) const {
        const int g = u.pm >> 2, rr0 = (u.pm & 3) * 256 + 64 * wr + fr;
#pragma unroll
        for (int ai = 0; ai < 2; ++ai)
#pragma unroll
            for (int m = 0; m < 4; ++m)
#pragma unroll
                for (int bj = 0; bj < 2; ++bj) {
                    const int rr = rr0 + 128 * ai + 16 * m, i = 8 * bj + 2 * wc + (fq >> 1), h0 = 8 * (fq & 1), tok = rr * TC + i;
                    const f32x4 v0 = acc[ai][bj][m][0], v1 = acc[ai][bj][m][1];
                    u32x4 w; w.x = pk2(fast_gelu(v0[0]), fast_gelu(v0[1])); w.y = pk2(fast_gelu(v0[2]), fast_gelu(v0[3])); w.z = pk2(fast_gelu(v1[0]), fast_gelu(v1[1])); w.w = pk2(fast_gelu(v1[2]), fast_gelu(v1[3]));
                    st16(ya + (size_t)tok * S5W + g * GH + h0, w);
                }
        return false;
    }
};
struct EpiGlu {
    static constexpr bool PERM = true, AFTER_DRAIN = false;
    const bf16_t* ya; bf16_t* yc;
    __device__ __forceinline__ bool operator()(Acc& acc, const Unit& u, int wr, int wc, int fr, int fq) const {
        const int row0 = u.pm * BM + wr * 64 + fr, col0 = u.pn * BM + wc * 32 + 8 * fq;
#pragma unroll
        for (int ai = 0; ai < 2; ++ai)
#pragma unroll
            for (int m = 0; m < 4; ++m)
#pragma unroll
                for (int bj = 0; bj < 2; ++bj) {
                    const size_t row = row0 + ai * HALF + m * 16; const int col = col0 + bj * HALF;
                    const u32x4 y = *(const u32x4*)(ya + row * S5W + col);
                    const f32x4 v0 = acc[ai][bj][m][0], v1 = acc[ai][bj][m][1];
                    u32x4 w;
                    w.x = pk2(bflo(y.x) * fast_sigmoid(v0[0]), bfhi(y.x) * fast_sigmoid(v0[1])); w.y = pk2(bflo(y.y) * fast_sigmoid(v0[2]), bfhi(y.y) * fast_sigmoid(v0[3]));
                    w.z = pk2(bflo(y.z) * fast_sigmoid(v1[0]), bfhi(y.z) * fast_sigmoid(v1[1])); w.w = pk2(bflo(y.w) * fast_sigmoid(v1[2]), bfhi(y.w) * fast_sigmoid(v1[3]));
                    st16(yc + row * D + col, w);
                }
        return false;
    }
};
struct EpiBranch {
    static constexpr bool PERM = true, AFTER_DRAIN = false;
    const bf16_t* gates; bf16_t* mg;
    __device__ __forceinline__ bool operator()(Acc& acc, const Unit& u, int wr, int wc, int fr, int fq) const {
        const int row0 = u.pm * BM + wr * 64 + fr, col0 = u.pn * BM + wc * 32 + 8 * fq;
        const int seg = u.seg;
#pragma unroll
        for (int ai = 0; ai < 2; ++ai)
#pragma unroll
            for (int m = 0; m < 4; ++m)
#pragma unroll
                for (int bj = 0; bj < 2; ++bj) {
                    const size_t row = row0 + ai * HALF + m * 16; const int col = col0 + bj * HALF;
                    const bf16_t* gp = gates + row * (3 * D) + col;
                    f32x4& v0 = acc[ai][bj][m][0]; f32x4& v1 = acc[ai][bj][m][1];
                    if (seg < 2) {
                        const u32x4 gn = *(const u32x4*)(gp + seg * D), gd = *(const u32x4*)(gp + (seg + 1) * D);
                        v0[0] *= bflo(gn.x) * __builtin_amdgcn_rcpf(bflo(gd.x)); v0[1] *= bfhi(gn.x) * __builtin_amdgcn_rcpf(bfhi(gd.x));
                        v0[2] *= bflo(gn.y) * __builtin_amdgcn_rcpf(bflo(gd.y)); v0[3] *= bfhi(gn.y) * __builtin_amdgcn_rcpf(bfhi(gd.y));
                        v1[0] *= bflo(gn.z) * __builtin_amdgcn_rcpf(bflo(gd.z)); v1[1] *= bfhi(gn.z) * __builtin_amdgcn_rcpf(bfhi(gd.z));
                        v1[2] *= bflo(gn.w) * __builtin_amdgcn_rcpf(bflo(gd.w)); v1[3] *= bfhi(gn.w) * __builtin_amdgcn_rcpf(bfhi(gd.w));
                    } else {
                        const u32x4 gc = *(const u32x4*)(gp + 2 * D);
                        u32x4 w;
                        w.x = pk2(v0[0] * bflo(gc.x), v0[1] * bfhi(gc.x)); w.y = pk2(v0[2] * bflo(gc.y), v0[3] * bfhi(gc.y));
                        w.z = pk2(v1[0] * bflo(gc.z), v1[1] * bfhi(gc.z)); w.w = pk2(v1[2] * bflo(gc.w), v1[3] * bfhi(gc.w));
                        st16(mg + row * D + col, w);
                    }
                }
        return seg < 2;
    }
};
}

#define XB_TMO      128
#define XB_XCNT(j)  (256  + 64 * (j))
#define XB_XSUB(j)  (1280 + 64 * (j))
#define XB_XGEN(j)  (2304 + 64 * (j))
#define XB_TOP      3328
#define XB_TOPGEN   3392
#define XCD_BAR_WORDS 3456
#define XB_SPIN_CAP (1u << 18)
__device__ __forceinline__ unsigned xb_ld(unsigned* p)              { return __hip_atomic_load(p, __ATOMIC_RELAXED, __HIP_MEMORY_SCOPE_AGENT); }
__device__ __forceinline__ unsigned xb_add(unsigned* p, unsigned v) { return __hip_atomic_fetch_add(p, v, __ATOMIC_RELAXED, __HIP_MEMORY_SCOPE_AGENT); }
__device__ __forceinline__ unsigned xb_xcc_id() { return (unsigned)__builtin_amdgcn_s_getreg((3 << 11) | 20) & 0xFu; }
#define XB_SPIN(cond, bar) do { unsigned _sp = 0; while (cond) { __builtin_amdgcn_s_sleep(1); \
    if ((++_sp & 255u) == 0u) { if (xb_ld(&(bar)[XB_TMO])) break; if (_sp > XB_SPIN_CAP) { atomicAdd(&(bar)[XB_TMO], 1u); break; } } } } while (0)
struct XcdBarrier { unsigned* bar; unsigned x; volatile LAS unsigned* st; };
__device__ __forceinline__ XcdBarrier xcd_barrier_post(unsigned* bar, volatile LAS unsigned* st, const int wv) {
    XcdBarrier b; b.bar = bar; b.x = xb_xcc_id(); b.st = st;
    if (tid_of(wv) == 0) (void)xb_add(&bar[XB_XCNT(b.x)], 1u);
    return b;
}
__device__ __forceinline__ void xcd_barrier_complete(unsigned* bar, unsigned x, unsigned& nloc, unsigned& nx) {
    const unsigned G = gridDim.x * gridDim.y * gridDim.z;
    unsigned sum, cnt, mine, sp = 0u;
    for (;;) {
        sum = 0u; cnt = 0u; mine = 0u;
#pragma unroll
        for (unsigned j = 0; j < 16; ++j) { const unsigned c = xb_ld(&bar[XB_XCNT(j)]); sum += c; cnt += (c > 0u) ? 1u : 0u; mine = (j == x) ? c : mine; }
        if (sum == G) break;
        __builtin_amdgcn_s_sleep(1);
        if ((++sp & 255u) == 0u) { if (xb_ld(&bar[XB_TMO])) break; if (sp > XB_SPIN_CAP) { atomicAdd(&bar[XB_TMO], 1u); break; } }
    }
    nloc = mine > 0u ? mine : 1u; nx = cnt > 0u ? cnt : 1u;
}
__device__ __forceinline__ void xcd_barrier(const XcdBarrier& b, const int wv) {
    asm volatile("s_waitcnt vmcnt(0)" ::: "memory");
    __syncthreads();
    if (tid_of(wv) == 0) {
        unsigned* bar = b.bar;
        __builtin_amdgcn_s_waitcnt(0);
        unsigned nloc = b.st[0], nx = b.st[1];
        if (nloc == 0u) { xcd_barrier_complete(bar, b.x, nloc, nx); b.st[0] = nloc; b.st[1] = nx; }
        const unsigned old = xb_add(&bar[XB_XSUB(b.x)], 1u);
        const unsigned gen = old / nloc;
        if (old + 1u == (gen + 1u) * nloc) {
            __builtin_amdgcn_fence(__ATOMIC_RELEASE, "agent");
            asm volatile("s_waitcnt vmcnt(0)" ::: "memory");
            const unsigned og = xb_add(&bar[XB_TOP], 1u);
            const unsigned tg = og / nx;
            if (og + 1u == (tg + 1u) * nx) xb_add(&bar[XB_TOPGEN], 1u);
            else XB_SPIN(xb_ld(&bar[XB_TOPGEN]) == tg, bar);
            __builtin_amdgcn_fence(__ATOMIC_ACQUIRE, "agent");
            xb_add(&bar[XB_XGEN(b.x)], 1u);
            asm volatile("s_waitcnt vmcnt(0)" ::: "memory");
        } else {
            XB_SPIN(xb_ld(&bar[XB_XGEN(b.x)]) == gen, bar);
            __builtin_amdgcn_fence(__ATOMIC_ACQUIRE, "agent");
            asm volatile("s_waitcnt vmcnt(0)" ::: "memory");
        }
    }
    __syncthreads();
}

struct Args { const float* in[35]; float* out; unsigned char* ws; int ph_lo, ph_hi; };
typedef const __attribute__((address_space(4))) Args* KArgP;
struct Frame {
    LAS unsigned char* lds; volatile LAS unsigned* MISC;
    int tid, lane, wave, vcu, G;
};
enum { I_XP = 0, I_XS, I_STATE, I_C, I_CCTX, I_WMOD, I_BMOD, I_NORMG, I_W1, I_W2, I_WIN, I_WGATE, I_BGATE, I_ARE, I_AIM, I_LOGDT, I_BRE, I_BIM, I_CRE, I_CIM, I_S5D, I_WGLU, I_WBRA,
       I_CONVW, I_CONVB, I_CLNG, I_CLNB, I_WBRB, I_SGLNG, I_SGLNB, I_SGW, I_SGB, I_WBRC, I_WOUT, I_FINALG };

__device__ __forceinline__ void p0_transpose_item(const float* src, int srcLd, bf16_t* dst, int dstLd, LAS float* scr, int lane) {
    const int r8 = lane >> 3, c4 = (lane & 7) * 4;
    f32x4 v[8];
#pragma unroll
    for (int i = 0; i < 8; ++i) v[i] = __builtin_nontemporal_load((const f32x4*)(src + (size_t)(r8 + 8 * i) * srcLd + c4));
#pragma unroll
    for (int i = 0; i < 8; ++i) { LAS float* p = scr + (r8 + 8 * i) * 33 + c4; p[0] = v[i][0]; p[1] = v[i][1]; p[2] = v[i][2]; p[3] = v[i][3]; }
    LDS_WAIT(); asm volatile("" ::: "memory");
    const int c = lane & 7;
#pragma unroll
    for (int j = 0; j < 4; ++j) { const int n = (lane >> 3) + 8 * j; const LAS float* s = scr + (8 * c) * 33 + n;
        u32x4 o; o.x = pk2(s[0 * 33], s[1 * 33]); o.y = pk2(s[2 * 33], s[3 * 33]); o.z = pk2(s[4 * 33], s[5 * 33]); o.w = pk2(s[6 * 33], s[7 * 33]);
        *(GAS u32x4*)(dst + (size_t)n * dstLd + 8 * c) = o; }
    LDS_WAIT(); asm volatile("" ::: "memory");
}
constexpr int J_W1 = 2 * 16 * 176, J_W2 = 2 * 44 * 32, J_WIN = 16 * 144, J_WGLU = 8 * 16, J_WBRA = 8 * 32, J_WBRB = 4 * 32, J_WBRC = 4 * 32, J_WOUT = 16 * 32;
constexpr int J_LAYER = J_W1 + J_W2 + J_WIN + J_WGLU + J_WBRA + J_WBRB + J_WBRC + J_WOUT;
constexpr int J_TRANS = J_LAYER;
constexpr int J_MOD = 2 * 16 * 36;
constexpr int J_PE = 256;
constexpr int J_ALL = J_TRANS + J_MOD + J_PE;

__device__ __forceinline__ void p0_trans(KArgP a, int it, LAS float* scr, int lane) {
    const int l = it / J_LAYER; int r = it % J_LAYER;
    bf16_t* wl = (bf16_t*)(a->ws + WS_W + (size_t)l * WL_SZ);
    if (r < J_W1) {
        const int f = r / (16 * 176); r %= 16 * 176; const int kb = r / 176, nb = r % 176, n0 = 32 * nb, tile = n0 >> 8, rr = n0 & 255, half = rr >> 7;
        const int scol = half * DFF + 128 * tile + (rr & 127);
        p0_transpose_item(a->in[I_W1] + ((size_t)(l * 2 + f) * D + 64 * kb) * (2 * DFF) + scol, 2 * DFF, wl + (WL_W1 + f * W1T_SZ) / 2 + (size_t)n0 * D + 64 * kb, D, scr, lane); return; }
    r -= J_W1;
    if (r < J_W2) {
        const int f = r / (44 * 32); r %= 44 * 32; const int kb = r / 32, nb = r % 32;
        p0_transpose_item(a->in[I_W2] + ((size_t)(l * 2 + f) * DFF + 64 * kb) * D + 32 * nb, D, wl + (WL_W2 + f * W2T_SZ) / 2 + (size_t)(32 * nb) * DFF + 64 * kb, DFF, scr, lane); return; }
    r -= J_W2;
    if (r < J_WIN) {
        const int kb = r / 144, nb = r % 144, n0 = 32 * nb; const float* src; int sld;
        if (n0 < 1536) { int scol = n0; if (n0 >= 512 && n0 < 1024) { const int q = n0 - 512, tile = q >> 8, rr = q & 255, half = rr >> 7; scol = 512 + half * 256 + 128 * tile + (rr & 127); }
            src = a->in[I_WIN] + ((size_t)l * D + 64 * kb) * INC + scol; sld = INC; }
        else { src = a->in[I_WGATE] + ((size_t)l * D + 64 * kb) * (3 * D) + (n0 - 1536); sld = 3 * D; }
        p0_transpose_item(src, sld, wl + WL_WIN / 2 + (size_t)n0 * D + 64 * kb, D, scr, lane); return; }
    r -= J_WIN;
    if (r < J_WGLU) { const int kb = r / 16, nb = r % 16;
        p0_transpose_item(a->in[I_WGLU] + ((size_t)l * S5W + 64 * kb) * S5W + 32 * nb, S5W, wl + WL_WGLU / 2 + (size_t)(32 * nb) * S5W + 64 * kb, S5W, scr, lane); return; }
    r -= J_WGLU;
    if (r < J_WBRA) { const int kb = r / 32, nb = r % 32;
        p0_transpose_item(a->in[I_WBRA] + ((size_t)l * S5W + 64 * kb) * D + 32 * nb, D, wl + WL_WBR / 2 + (size_t)(32 * nb) * D + 64 * kb, D, scr, lane); return; }
    r -= J_WBRA;
    if (r < J_WBRB) { const int kb = r / 32, nb = r % 32;
        p0_transpose_item(a->in[I_WBRB] + ((size_t)l * CW + 64 * kb) * D + 32 * nb, D, wl + WL_WBR / 2 + (size_t)(32 * nb) * D + 512 + 64 * kb, D, scr, lane); return; }
    r -= J_WBRB;
    if (r < J_WBRC) { const int kb = r / 32, nb = r % 32;
        p0_transpose_item(a->in[I_WBRC] + ((size_t)l * SGW + 64 * kb) * D + 32 * nb, D, wl + WL_WBR / 2 + (size_t)(32 * nb) * D + 768 + 64 * kb, D, scr, lane); return; }
    r -= J_WBRC;
    { const int kb = r / 32, nb = r % 32;
        p0_transpose_item(a->in[I_WOUT] + ((size_t)l * D + 64 * kb) * D + 32 * nb, D, wl + WL_WOUT / 2 + (size_t)(32 * nb) * D + 64 * kb, D, scr, lane); }
}
__device__ __forceinline__ void p0_mod(KArgP a, int r, LAS float* scr, int lane, const float wgt) {
    const int l = r / (16 * 36); r %= 16 * 36; const int ks = r / 36, nb = r % 36, k0 = 64 * ks, n0 = 256 * nb + 4 * lane;
#pragma unroll
    for (int c = 0; c < 9; ++c) { const float v = c == 0 ? a->in[I_CCTX][k0 + lane] : a->in[I_C][(size_t)(c - 1) * D + k0 + lane]; scr[c * 64 + lane] = fast_silu(v); }
    LDS_WAIT(); asm volatile("" ::: "memory");
    f32x4 acc[9];
#pragma unroll
    for (int c = 0; c < 9; ++c) acc[c] = (f32x4){0.f, 0.f, 0.f, 0.f};
    const float* W = a->in[I_WMOD] + ((size_t)l * D + k0) * (NMOD * D) + n0;
#pragma unroll 16
    for (int k = 0; k < 64; ++k) { const f32x4 w = __builtin_nontemporal_load((const f32x4*)(W + (size_t)k * (NMOD * D)));
#pragma unroll
        for (int c = 0; c < 9; ++c) acc[c] += w * scr[c * 64 + k]; }
    float* mod = (float*)(a->ws + WS_MOD) + (size_t)l * 9 * (NMOD * D) + n0;
    f32x4 bias = (f32x4){0.f, 0.f, 0.f, 0.f};
    if (ks == 0) bias = *(const f32x4*)(a->in[I_BMOD] + (size_t)l * NMOD * D + n0);
#pragma unroll
    for (int c = 0; c < 9; ++c) { const f32x4 v = (acc[c] + bias) * wgt;
#pragma unroll
        for (int e = 0; e < 4; ++e) atomicAdd(mod + (size_t)c * (NMOD * D) + e, v[e]); }
    LDS_WAIT(); asm volatile("" ::: "memory");
}
__device__ __forceinline__ void p0_pe(KArgP a, int r, int lane) {
    const int e = r * 64 + lane, pos = e >> 8, i = e & 255;
    const double omega = 1.0 / pow(10000.0, (double)i / 256.0), ang = (double)pos * omega;
    float* pe = (float*)(a->ws + WS_PE);
    *(f32x2*)(pe + (size_t)e * 2) = (f32x2){(float)sin(ang), (float)cos(ang)};
}
__device__ __forceinline__ void p0_s5(KArgP a, const Frame& F, int l, int g) {
    LAS f32x2* PW = (LAS f32x2*)F.lds; LAS f32x2* BB = PW + 2 * 64 * 17; LAS f32x2* CC = BB + 2 * 64 * 16; LAS float* KFf = (LAS float*)(CC + 2 * 16 * 64); LAS float* KFb = KFf + 4096;
    const int tid = F.tid;
    if (tid < 128) {
        const int dir = tid >> 6, p = tid & 63, ig = (l * 2 + dir) * NG + g, ip = ig * NP + p;
        f32x4 br4[4], bi4[4]; float cr[16], ci[16];
#pragma unroll
        for (int q = 0; q < 4; ++q) { br4[q] = *(const f32x4*)(a->in[I_BRE] + (size_t)ip * GH + 4 * q); bi4[q] = *(const f32x4*)(a->in[I_BIM] + (size_t)ip * GH + 4 * q); }
#pragma unroll
        for (int h = 0; h < 16; ++h) { cr[h] = a->in[I_CRE][((size_t)ig * GH + h) * NP + p]; ci[h] = a->in[I_CIM][((size_t)ig * GH + h) * NP + p]; }
        const double are = a->in[I_ARE][ip], aim = a->in[I_AIM][ip], dt = exp((double)a->in[I_LOGDT][ig]);
        const double mag = exp(are * dt), abr = mag * cos(aim * dt), abi = mag * sin(aim * dt);
        const double den = are * are + aim * aim, nr = abr - 1.0, ni = abi;
        const double qr = (nr * are + ni * aim) / den, qi = (ni * are - nr * aim) / den;
        double pr = 1.0, pi = 0.0;
        for (int d = 0; d <= 16; ++d) { PW[(dir * 64 + p) * 17 + d] = (f32x2){(float)pr, (float)pi}; const double t = pr * abr - pi * abi; pi = pr * abi + pi * abr; pr = t; }
        const f32x2 a16 = PW[(dir * 64 + p) * 17 + 16];
        *(f32x2*)((float*)(a->ws + WS_AT) + ((size_t)(ig) * NP + p) * 2) = a16;
        const float qrf = (float)qr, qif = (float)qi;
#pragma unroll
        for (int h = 0; h < 16; ++h) {
            const float br = br4[h >> 2][h & 3], bi = bi4[h >> 2][h & 3];
            BB[(dir * 64 + p) * 16 + h] = (f32x2){qrf * br - qif * bi, qrf * bi + qif * br};
            CC[(dir * 16 + h) * 64 + p] = (f32x2){cr[h], ci[h]};
        }
    }
    LDS_WAIT(); __syncthreads();
    {
        const int dir = tid >> 8, d = (tid >> 4) & 15, hp = tid & 15;
        float acc[16];
#pragma unroll
        for (int h = 0; h < 16; ++h) acc[h] = 0.f;
        for (int p = 0; p < 64; ++p) {
            const f32x2 w = PW[(dir * 64 + p) * 17 + d], b = BB[(dir * 64 + p) * 16 + hp];
            const float er = w.x * b.x - w.y * b.y, ei = w.x * b.y + w.y * b.x;
#pragma unroll
            for (int h = 0; h < 16; ++h) { const f32x2 c = CC[(dir * 16 + h) * 64 + p]; acc[h] += c.x * er - c.y * ei; }
        }
        LAS float* KFd = dir == 0 ? KFf : KFb;
#pragma unroll
        for (int h = 0; h < 16; ++h) KFd[(d * 16 + h) * 16 + hp] = acc[h];
    }
    LDS_WAIT(); __syncthreads();
    bf16_t* KP = (bf16_t*)(a->ws + WS_KP) + (size_t)(l * NG + g) * 256 * 512;
    for (int e = tid; e < 256 * 64; e += 512) {
        const int n = e >> 6, kc = (e & 63) * 8, i = n >> 4, h = n & 15;
        float v[8];
        if (kc < 256) { const int j = kc >> 4, hp0 = kc & 15, dl = i - j;
            if (dl > 0) {
#pragma unroll
                for (int q = 0; q < 8; ++q) v[q] = KFf[(dl * 16 + h) * 16 + hp0 + q];
            } else if (dl < 0) {
#pragma unroll
                for (int q = 0; q < 8; ++q) v[q] = KFb[(-dl * 16 + h) * 16 + hp0 + q];
            } else { const float dd = a->in[I_S5D][(size_t)l * S5W + g * GH + h];
#pragma unroll
                for (int q = 0; q < 8; ++q) v[q] = KFf[h * 16 + hp0 + q] + KFb[h * 16 + hp0 + q] + ((hp0 + q) == h ? dd : 0.f);
            } }
        else { const int kk = kc - 256, dir = kk >> 7, reim = (kk >> 6) & 1, p0 = kk & 63, ex = dir == 0 ? i + 1 : 16 - i;
#pragma unroll
            for (int q = 0; q < 8; ++q) { const f32x2 c = CC[(dir * 16 + h) * 64 + p0 + q], w = PW[(dir * 64 + p0 + q) * 17 + ex];
                v[q] = reim == 0 ? (c.x * w.x - c.y * w.y) : -(c.x * w.y + c.y * w.x); } }
        u32x4 o; o.x = pk2(v[0], v[1]); o.y = pk2(v[2], v[3]); o.z = pk2(v[4], v[5]); o.w = pk2(v[6], v[7]);
        *(GAS u32x4*)(KP + (size_t)n * 512 + kc) = o;
    }
    bf16_t* PIN = (bf16_t*)(a->ws + WS_PIN) + (size_t)(l * NG + g) * 256 * 256;
    for (int e = tid; e < 256 * 32; e += 512) {
        const int n = e >> 5, kc = (e & 31) * 8, dir = n >> 7, reim = (n >> 6) & 1, p = n & 63, j = kc >> 4, hp0 = kc & 15, ex = dir == 0 ? 15 - j : j;
        const f32x2 w = PW[(dir * 64 + p) * 17 + ex];
        float v[8];
#pragma unroll
        for (int q = 0; q < 8; ++q) { const f32x2 b = BB[(dir * 64 + p) * 16 + hp0 + q]; v[q] = reim == 0 ? (w.x * b.x - w.y * b.y) : (w.x * b.y + w.y * b.x); }
        u32x4 o; o.x = pk2(v[0], v[1]); o.y = pk2(v[2], v[3]); o.z = pk2(v[4], v[5]); o.w = pk2(v[6], v[7]);
        *(GAS u32x4*)(PIN + (size_t)n * 256 + kc) = o;
    }
    LDS_WAIT(); __syncthreads();
}
__device__ __forceinline__ void p0_prologue(KArgP a, const Frame& F, const bool rep = false) {
    const int parts = rep ? REP0_PARTS : 15;
    if ((parts & 1) && F.vcu < 2 * NG) p0_s5(a, F, F.vcu / NG, F.vcu % NG);
    LAS float* scr = (LAS float*)(F.lds + F.wave * 16384);
    const int gw = F.vcu * NWAVES + F.wave, NGW = F.G * NWAVES;
    for (int it = gw; it < J_ALL; it += NGW) {
        if (it < J_MOD) { if (parts & 2) p0_mod(a, it, scr, F.lane, rep ? 0.f : 1.f); }
        else if (it < J_MOD + J_PE) { if (parts & 4) p0_pe(a, it - J_MOD, F.lane); }
        else { if (parts & 8) p0_trans(a, it - J_MOD - J_PE, scr, F.lane); }
    }
}

__device__ __forceinline__ void shw_tasks(KArgP a, const int l, const int gw, const int NGW, const int lane) {
    constexpr int T0 = 2 * DFF / 16, T1 = NIN / 16, TL = 2 * T0 + T1;
    const float* mod0 = (const float*)(a->ws + WS_MOD);
    const int cnd = lane & 15, kq = lane >> 4;
    for (int task = gw; task < TL; task += NGW) {
        int t = task; int sub, nb;
        if (t < T0) { sub = 0; nb = t; } else if (t < T0 + T1) { sub = 1; nb = t - T0; } else { sub = 2; nb = t - T0 - T1; }
        const char* wl = (const char*)(a->ws + WS_W + (size_t)l * WL_SZ);
        const bf16_t* Wt = (const bf16_t*)(sub == 1 ? wl + WL_WIN : wl + WL_W1 + (sub == 2 ? W1T_SZ : 0));
        const float* shp = mod0 + (size_t)l * 9 * (NMOD * D) + (size_t)(cnd < 9 ? cnd : 0) * (NMOD * D) + (3 * sub) * D + 8 * kq;
        const bf16_t* wp = Wt + (size_t)(16 * nb + cnd) * D + 8 * kq;
        f32x4 acc = (f32x4){0.f, 0.f, 0.f, 0.f};
#pragma unroll 8
        for (int kk = 0; kk < 32; ++kk) {
            const f32x4 s0 = *(const f32x4*)(shp + 32 * kk), s1 = *(const f32x4*)(shp + 32 * kk + 4);
            u32x4 au; au.x = pk2(s0[0], s0[1]); au.y = pk2(s0[2], s0[3]); au.z = pk2(s1[0], s1[1]); au.w = pk2(s1[2], s1[3]);
            if (cnd >= 9) au = (u32x4){0u, 0u, 0u, 0u};
            const bf16x8 bw = *(const bf16x8*)(wp + 32 * kk);
            acc = __builtin_amdgcn_mfma_f32_16x16x32_bf16(__builtin_bit_cast(bf16x8, au), bw, acc, 0, 0, 0);
        }
        float* out = (float*)(a->ws + WS_SHW) + (size_t)(3 * l + sub) * 9 * SHW_LD + 16 * nb + cnd;
#pragma unroll
        for (int r = 0; r < 4; ++r) { const int c2 = 4 * kq + r; if (c2 < 9) out[(size_t)c2 * SHW_LD] = acc[r]; }
    }
}
__device__ __forceinline__ void deferred_l1(KArgP a, const Frame& F, const int part, const int wi, const int nw) {
    LAS float* scr = (LAS float*)(F.lds + F.wave * 16384);
    if (part == 0) { for (int i = wi; i < J_W1 + J_WIN; i += nw) p0_trans(a, J_LAYER + (i < J_W1 ? i : i + J_W2), scr, F.lane); }
    else { for (int i = wi; i < J_LAYER - J_W1 - J_WIN; i += nw) p0_trans(a, J_LAYER + (i < J_W2 ? J_W1 + i : i + J_W1 + J_WIN), scr, F.lane);
           shw_tasks(a, 1, wi, nw, F.lane); }
}
__device__ __forceinline__ void embed_phase(KArgP a, const Frame& F) {
    const int gw = F.vcu * NWAVES + F.wave, NGW = F.G * NWAVES, lane = F.lane;
    float* X = a->out; bf16_t* H = (bf16_t*)(a->ws + WS_H);
    const float* gam = a->in[I_NORMG];
    const float* mod0 = (const float*)(a->ws + WS_MOD);
    const float* pe = (const float*)(a->ws + WS_PE);
    float* ssq = (float*)(a->ws + WS_SSQ);
    for (int row = gw; row < M; row += NGW) {
        f32x4 v[4]; float s = 0.f;
        if (row < MCTX) {
#pragma unroll
            for (int j = 0; j < 4; ++j) v[j] = *(const f32x4*)(a->in[I_XP] + (size_t)row * D + 4 * lane + 256 * j);
        } else {
            const int t = (row - MCTX) & (SMPL - 1), rr = t >> 6, cc = t & 63;
#pragma unroll
            for (int j = 0; j < 4; ++j) { v[j] = *(const f32x4*)(a->in[I_XS] + (size_t)(row - MCTX) * D + 4 * lane + 256 * j);
                const int pos = j < 2 ? rr : cc;
#pragma unroll
                for (int e = 0; e < 4; ++e) v[j][e] += pe[((size_t)pos * 256 + 4 * lane + e) * 2 + (j & 1)]; }
        }
#pragma unroll
        for (int j = 0; j < 4; ++j) { *(f32x4*)(X + (size_t)row * D + 4 * lane + 256 * j) = v[j]; s += (v[j][0] * v[j][0] + v[j][1] * v[j][1]) + (v[j][2] * v[j][2] + v[j][3] * v[j][3]); }
        s = wave_sum(s);
        if (lane == 0) ssq[row] = s;
        const float* md = mod0 + (size_t)cond_of_row(row) * (NMOD * D);
#pragma unroll
        for (int j = 0; j < 4; ++j) { const int d = 4 * lane + 256 * j;
            const f32x4 o = v[j] * *(const f32x4*)(gam + d) * (*(const f32x4*)(md + D + d) + 1.f);
            u32x2 w; w.x = pk2(o[0], o[1]); w.y = pk2(o[2], o[3]);
            *(u32x2*)(H + (size_t)row * D + d) = w; }
    }
    shw_tasks(a, 0, gw, NGW, lane);
}
template <class Sched> __device__ __forceinline__ pg8::Stash stash_units(const Sched& S, LAS unsigned char* lds, const float* ssq, const float* shw, const float* bgate  , const int wv) {
    LAS float* sr = (LAS float*)(lds + STASH_OFF); LAS float* ss = sr + STASH_UNITS * 256;
    int tid = tid_of(wv); asm volatile("" : "+v"(tid));
    for (int i = 0; i < STASH_UNITS; ++i) { pg8::Unit u; if (!S.next(i, u)) break;
        if (tid < 256) sr[i * 256 + tid] = rsqrtf(ssq[u.pm * 256 + tid] * (1.f / D) + EPS);
        else { const int c = u.pn * 256 + (tid - 256); float v = shw[(size_t)cond_of_tile(u.pm) * SHW_LD + c]; if (bgate && c >= INC) v += bgate[c - INC]; ss[i * 256 + tid - 256] = v; } }
    LDS_WAIT(); __syncthreads();
    return pg8::Stash{sr, ss};
}
__device__ __forceinline__ void final_phase(KArgP a, const Frame& F) {
    const int gw = F.vcu * NWAVES + F.wave, NGW = F.G * NWAVES, lane = F.lane;
    float* X = a->out; const float* gam = a->in[I_FINALG];
    for (int row = gw; row < M; row += NGW) {
        f32x4 v[4]; float s = 0.f;
#pragma unroll
        for (int j = 0; j < 4; ++j) { v[j] = *(const f32x4*)(X + (size_t)row * D + 4 * lane + 256 * j); s += (v[j][0] * v[j][0] + v[j][1] * v[j][1]) + (v[j][2] * v[j][2] + v[j][3] * v[j][3]); }
        const float r = rsqrtf(wave_sum(s) * (1.f / D) + EPS);
#pragma unroll
        for (int j = 0; j < 4; ++j) { const int d = 4 * lane + 256 * j; *(f32x4*)(X + (size_t)row * D + d) = v[j] * r * *(const f32x4*)(gam + d); }
    }
}

constexpr int SG_V_OFF = 32768;
__device__ __forceinline__ void conv_item(KArgP a, const Frame& F, int l, int item) {
    const int tok0 = item * 64;
    int s0, s1; if (tok0 < MCTX) { s0 = tok0 & ~(CTXL - 1); s1 = s0 + CTXL; } else { s0 = MCTX + ((tok0 - MCTX) & ~(SMPL - 1)); s1 = s0 + SMPL; }
    const bf16_t* CG = (const bf16_t*)(a->ws + WS_CG);
    LAS unsigned char* Gt = F.lds;
    LAS float* Wt = (LAS float*)(F.lds + 49152);
    const float* cw = a->in[I_CONVW] + (size_t)l * CK * CW;
    u32x4 gl[6]; f32x4 wv[4];
#pragma unroll
    for (int i = 0; i < 6; ++i) { const int q = F.tid + 512 * i, row = q >> 5, cc = q & 31, tok = tok0 - 15 + row;
        gl[i] = (u32x4){0u, 0u, 0u, 0u}; if (q < 94 * 32 && tok >= s0 && tok < s1) gl[i] = *(const u32x4*)(CG + (size_t)tok * CW + cc * 8); }
#pragma unroll
    for (int i = 0; i < 4; ++i) { const int q = F.tid + 512 * i; wv[i] = (f32x4){0.f, 0.f, 0.f, 0.f}; if (q < CK * CW / 4) wv[i] = *(const f32x4*)(cw + 4 * q); }
#pragma unroll
    for (int i = 0; i < 6; ++i) { const int q = F.tid + 512 * i, row = q >> 5, cc = q & 31; if (q < 94 * 32) *(LAS u32x4*)(Gt + row * 512 + cc * 16) = gl[i]; }
#pragma unroll
    for (int i = 0; i < 4; ++i) { const int q = F.tid + 512 * i; if (q < CK * CW / 4) *(LAS f32x4*)(Wt + 4 * q) = wv[i]; }
    const int lane = F.lane, c0 = 4 * lane;
    const f32x4 bias = *(const f32x4*)(a->in[I_CONVB] + (size_t)l * CW + c0), lg = *(const f32x4*)(a->in[I_CLNG] + (size_t)l * CW + c0), lb = *(const f32x4*)(a->in[I_CLNB] + (size_t)l * CW + c0);
    LDS_WAIT(); __syncthreads();
    bf16_t* YC = (bf16_t*)(a->ws + WS_H);
    const int tl0 = 8 * F.wave;
    f32x4 acc[8];
#pragma unroll
    for (int t = 0; t < 8; ++t) acc[t] = bias;
#pragma unroll 1
    for (int k = 0; k < CK; ++k) { const f32x4 w = *(const LAS f32x4*)(Wt + k * CW + c0);
#pragma unroll
        for (int t = 0; t < 8; ++t) { const u32x2 gv = *(const LAS u32x2*)(Gt + (tl0 + t + k) * 512 + lane * 8);
            acc[t][0] += w[0] * bflo(gv.x); acc[t][1] += w[1] * bfhi(gv.x); acc[t][2] += w[2] * bflo(gv.y); acc[t][3] += w[3] * bfhi(gv.y); } }
    float mu[8], q2[8];
#pragma unroll
    for (int t = 0; t < 8; ++t) mu[t] = (acc[t][0] + acc[t][1]) + (acc[t][2] + acc[t][3]);
#pragma unroll
    for (int o = 1; o < 64; o <<= 1)
#pragma unroll
        for (int t = 0; t < 8; ++t) mu[t] += __shfl_xor(mu[t], o);
#pragma unroll
    for (int t = 0; t < 8; ++t) { mu[t] *= (1.f / CW); acc[t] = acc[t] - mu[t]; q2[t] = (acc[t][0] * acc[t][0] + acc[t][1] * acc[t][1]) + (acc[t][2] * acc[t][2] + acc[t][3] * acc[t][3]); }
#pragma unroll
    for (int o = 1; o < 64; o <<= 1)
#pragma unroll
        for (int t = 0; t < 8; ++t) q2[t] += __shfl_xor(q2[t], o);
#pragma unroll
    for (int t = 0; t < 8; ++t) {
        const float rstd = rsqrtf(q2[t] * (1.f / CW) + EPS);
        const f32x4 y = acc[t] * rstd * lg + lb;
        u32x2 w; w.x = pk2(fast_silu(y[0]), fast_silu(y[1])); w.y = pk2(fast_silu(y[2]), fast_silu(y[3]));
        *(u32x2*)(YC + (size_t)(tok0 + tl0 + t) * D + 512 + c0) = w;
    }
    LDS_WAIT(); __syncthreads();
}
__device__ __forceinline__ void sg_wave_item(KArgP a, const Frame& F, int l, int witem) {
    const int cb = witem & 1, h = (witem >> 1) & 3, cidx = witem >> 3, tb = cidx * SGC, lane = F.lane, c0 = 64 * h + 32 * cb;
    const bf16_t* SU = (const bf16_t*)(a->ws + WS_SU); const bf16_t* SV = (const bf16_t*)(a->ws + WS_SV); const float* ST = (const float*)(a->ws + WS_SVST);
    LAS bf16_t* Vw = (LAS bf16_t*)(F.lds + SG_V_OFF + F.wave * 8192);
    {
        const int c8 = (lane & 3) * 8, rb = lane >> 2;
        u32x4 raw[8]; f32x4 t0[8], t1[8];
#pragma unroll
        for (int i = 0; i < 8; ++i) { const size_t tok = tb + rb + 16 * i; raw[i] = *(const u32x4*)(SV + tok * SGW + c0 + c8); t0[i] = *(const f32x4*)(ST + tok * 8); t1[i] = *(const f32x4*)(ST + tok * 8 + 4); }
        const float* gp = a->in[I_SGLNG] + (size_t)l * SGW + c0 + c8; const float* bp = a->in[I_SGLNB] + (size_t)l * SGW + c0 + c8;
        const f32x4 lg0 = *(const f32x4*)gp, lg1 = *(const f32x4*)(gp + 4), lb0 = *(const f32x4*)bp, lb1 = *(const f32x4*)(bp + 4);
#pragma unroll
        for (int i = 0; i < 8; ++i) {
            const float mu = ((t0[i][0] + t0[i][2]) + (t1[i][0] + t1[i][2])) * (1.f / SGW), ex2 = ((t0[i][1] + t0[i][3]) + (t1[i][1] + t1[i][3])) * (1.f / SGW);
            const float rstd = rsqrtf(fmaxf(ex2 - mu * mu, 0.f) + EPS);
            const f32x4 v0 = (f32x4){bflo(raw[i].x), bfhi(raw[i].x), bflo(raw[i].y), bfhi(raw[i].y)}, v1 = (f32x4){bflo(raw[i].z), bfhi(raw[i].z), bflo(raw[i].w), bfhi(raw[i].w)};
            const f32x4 y0 = (v0 - mu) * rstd * lg0 + lb0, y1 = (v1 - mu) * rstd * lg1 + lb1;
            u32x4 o; o.x = pk2(y0[0], y0[1]); o.y = pk2(y0[2], y0[3]); o.z = pk2(y1[0], y1[1]); o.w = pk2(y1[2], y1[3]);
            *(LAS u32x4*)(Vw + (rb + 16 * i) * 32 + c8) = o;
        }
    }
    LDS_WAIT(); asm volatile("" ::: "memory");
    const int h2 = lane >> 5, ci = lane & 31;
    u32x4 av[8];
#pragma unroll
    for (int ks = 0; ks < 8; ++ks) { const LAS bf16_t* vp = Vw + (16 * ks + 8 * h2) * 32 + ci;
        av[ks].x = (unsigned)vp[0] | ((unsigned)vp[32] << 16); av[ks].y = (unsigned)vp[64] | ((unsigned)vp[96] << 16); av[ks].z = (unsigned)vp[128] | ((unsigned)vp[160] << 16); av[ks].w = (unsigned)vp[192] | ((unsigned)vp[224] << 16); }
    bf16_t* YC = (bf16_t*)(a->ws + WS_H);
#pragma unroll 1
    for (int qb = 0; qb < 4; ++qb) {
        const int q = 32 * qb + ci; const size_t tok = tb + q;
        const float* Wh = a->in[I_SGW] + ((size_t)(l * SGH + h) * SGC + q) * SGC + 8 * h2;
        f32x4 w0[8], w1[8];
#pragma unroll
        for (int ks = 0; ks < 8; ++ks) { w0[ks] = *(const f32x4*)(Wh + 16 * ks); w1[ks] = *(const f32x4*)(Wh + 16 * ks + 4); }
        u32x2 suv[4];
#pragma unroll
        for (int jg = 0; jg < 4; ++jg) suv[jg] = *(const u32x2*)(SU + tok * SGW + c0 + 8 * jg + 4 * h2);
        const float sbv = a->in[I_SGB][(size_t)(l * SGH + h) * SGC + q];
        f32x16 acc;
#pragma unroll
        for (int i = 0; i < 16; ++i) acc[i] = 0.f;
#pragma unroll
        for (int ks = 0; ks < 8; ++ks) {
            u32x4 bu; bu.x = pk2(w0[ks][0], w0[ks][1]); bu.y = pk2(w0[ks][2], w0[ks][3]); bu.z = pk2(w1[ks][0], w1[ks][1]); bu.w = pk2(w1[ks][2], w1[ks][3]);
            acc = __builtin_amdgcn_mfma_f32_32x32x16_bf16(__builtin_bit_cast(bf16x8, av[ks]), __builtin_bit_cast(bf16x8, bu), acc, 0, 0, 0);
        }
#pragma unroll
        for (int jg = 0; jg < 4; ++jg) {
            const float u0 = bflo(suv[jg].x), u1 = bfhi(suv[jg].x), u2 = bflo(suv[jg].y), u3 = bfhi(suv[jg].y);
            u32x2 o; o.x = pk2(u0 * (acc[4 * jg] + sbv), u1 * (acc[4 * jg + 1] + sbv)); o.y = pk2(u2 * (acc[4 * jg + 2] + sbv), u3 * (acc[4 * jg + 3] + sbv));
            *(u32x2*)(YC + tok * D + 768 + c0 + 8 * jg + 4 * h2) = o;
        }
    }
    LDS_WAIT(); asm volatile("" ::: "memory");
}

constexpr int PH_PER_LAYER = 10, PH_L0 = 2, N_PHASES = PH_L0 + DEPTH * PH_PER_LAYER + 1;

__device__ __forceinline__ Frame make_frame(LAS unsigned char* lds, const int wv) {
    Frame F;
    F.lds = lds; F.MISC = (volatile LAS unsigned*)(lds + MISC_OFF);
    { int t = tid_of(wv); asm volatile("" : "+v"(t)); F.tid = t; }
    F.lane = F.tid & 63; F.wave = wv;
    F.G = gridDim.x; { const int bx = blockIdx.x; F.vcu = (F.G % 8 == 0) ? (bx % 8) * (F.G / 8) + bx / 8 : bx; }
    return F;
}

__device__ __forceinline__ void layer_phase(KArgP args, const int l, const int k, LAS unsigned char* ring, const bool rep, const int wv) {
    unsigned char* ws = args->ws;
    int G = gridDim.x, cid = (int)blockIdx.x; asm volatile("" : "+s"(G), "+s"(cid));
    const char* wl = (const char*)(ws + WS_W + (size_t)l * WL_SZ);
    const float* mod0 = (const float*)(ws + WS_MOD);
    const float* modl = mod0 + (size_t)l * 9 * (NMOD * D);
    float* ssq0 = (float*)(ws + WS_SSQ);
    const float* shw0 = (const float*)(ws + WS_SHW);
    if (k == 0 || k == 8) {
        const int f = k == 0 ? 0 : 1, site = 3 * l + 2 * f;
        pg8::PlainSched S; S.T.init(M / 256, 2 * DFF / 256, G, cid); S.A = (const char*)(ws + WS_H); S.Bt = wl + WL_W1 + f * W1T_SZ;
        S.aStride = 256L * D * 2; S.bStride = 256L * D * 2; S.bgStride = 0; S.bgShift = 0; S.nt = D / 64;
        const pg8::Stash st = stash_units(S, ring, ssq0 + (size_t)site * M, shw0 + (size_t)site * 9 * SHW_LD, nullptr, wv);
        pg8::EpiSwiGLU E{(bf16_t*)(ws + WS_HID), st};
        pg8::gemm_phase<pg8::EpiSwiGLU, pg8::PlainSched, true, true>(ring, D, D, S, E, wv);
    } else if (k == 1 || k == 9 || k == 7) {
        const bool is_out = k == 7; const int f = k == 1 ? 0 : 1;
        const int kk = is_out ? D : DFF;
        pg8::PlainSched S; S.T.init(M / 256, D / 256, G, cid); S.A = (const char*)(ws + (is_out ? WS_MG : WS_HID)); S.Bt = is_out ? wl + WL_WOUT : wl + WL_W2 + f * W2T_SZ;
        S.aStride = 256L * kk * 2; S.bStride = 256L * kk * 2; S.bgStride = 0; S.bgShift = 0; S.nt = kk / 64;
        const int nl = k == 9 ? l + 1 : l, nsub = k == 1 ? 1 : (k == 7 ? 2 : 0);
        const bool has_next = !rep && nl < DEPTH;
        pg8::EpiResid E{args->out, modl, is_out ? 1 : (f == 0 ? 0 : 2), rep ? 0.f : (is_out ? 1.0f : 0.5f),
                        has_next ? (bf16_t*)(ws + WS_H) : nullptr, args->in[I_NORMG] + (size_t)((has_next ? nl : 0) * 3 + nsub) * D, mod0 + (size_t)(has_next ? nl : 0) * 9 * (NMOD * D), nsub,
                        ssq0 + (size_t)(3 * (has_next ? nl : 0) + nsub) * M};
        pg8::gemm_phase<pg8::EpiResid, pg8::PlainSched, true, true>(ring, kk, kk, S, E, wv);
    } else if (k == 2) {
        const int site = 3 * l + 1;
        pg8::PlainSched S; S.T.init(M / 256, NIN / 256, G, cid); S.A = (const char*)(ws + WS_H); S.Bt = wl + WL_WIN;
        S.aStride = 256L * D * 2; S.bStride = 256L * D * 2; S.bgStride = 0; S.bgShift = 0; S.nt = D / 64;
        const pg8::Stash st = stash_units(S, ring, ssq0 + (size_t)site * M, shw0 + (size_t)site * 9 * SHW_LD, args->in[I_BGATE] + (size_t)l * 3 * D, wv);
        pg8::EpiMixIn E{(bf16_t*)(ws + WS_YCAT), (bf16_t*)(ws + WS_CG), (bf16_t*)(ws + WS_SU), (bf16_t*)(ws + WS_SV), (bf16_t*)(ws + WS_GATES), (float*)(ws + WS_SVST), st};
        pg8::gemm_phase<pg8::EpiMixIn, pg8::PlainSched, true, true>(ring, D, D, S, E, wv);
    } else if (k == 3) {
        pg8::PlainSched S; S.T.init(NG * YR / 256, 1, G, cid); S.A = (const char*)(ws + WS_YCAT); S.Bt = (const char*)(ws + WS_PIN) + (size_t)l * NG * 256 * 256 * 2;
        S.aStride = 256L * 512 * 2; S.bStride = 0; S.bgStride = 256L * 256 * 2; S.bgShift = 2; S.nt = 4;
        pg8::EpiS5X E{(bf16_t*)(ws + WS_YCAT), (const float*)(ws + WS_AT) + (size_t)l * 2 * NG * NP * 2, args->in[I_STATE], args->out + (size_t)M * D, l};
        const int parts = rep ? REP5_PARTS : 7;
        if (parts & 1) pg8::gemm_phase<pg8::EpiS5X, pg8::PlainSched, false, true>(ring, 512, 256, S, E, wv);
        const int nx = NG * YR / 256;
        if (cid >= nx) {
            const Frame F = make_frame(ring, wv);
            const int wi = (cid - nx) * NWAVES + F.wave, nw = (G - nx) * NWAVES;
            if (parts & 4) for (int it = wi; it < (M / SGC) * SGH * 2; it += nw) sg_wave_item(args, F, l, it);
            __syncthreads();
            if (parts & 2) for (int it = cid - nx; it < M / 64; it += G - nx) conv_item(args, F, l, it);
        }
    } else if (k == 4) {
        pg8::PlainSched S; S.T.init(NG * YR / 256, 1, G, cid); S.A = (const char*)(ws + WS_YCAT); S.Bt = (const char*)(ws + WS_KP) + (size_t)l * NG * 256 * 512 * 2;
        S.aStride = 256L * 512 * 2; S.bStride = 0; S.bgStride = 256L * 512 * 2; S.bgShift = 2; S.nt = 8;
        pg8::EpiS5Y E{(bf16_t*)(ws + WS_YA)};
        pg8::gemm_phase<pg8::EpiS5Y, pg8::PlainSched, true, true>(ring, 512, 512, S, E, wv);
        if (l == 0 && cid >= NG * YR / 256) { const Frame F = make_frame(ring, wv); deferred_l1(args, F, 0, (cid - NG * YR / 256) * NWAVES + F.wave, (G - NG * YR / 256) * NWAVES); }
    } else if (k == 5) {
        pg8::PlainSched S; S.T.init(M / 256, S5W / 256, G, cid); S.A = (const char*)(ws + WS_YA); S.Bt = wl + WL_WGLU;
        S.aStride = 256L * S5W * 2; S.bStride = 256L * S5W * 2; S.bgStride = 0; S.bgShift = 0; S.nt = S5W / 64;
        pg8::EpiGlu E{(const bf16_t*)(ws + WS_YA), (bf16_t*)(ws + WS_H)};
        pg8::gemm_phase<pg8::EpiGlu, pg8::PlainSched, true, true>(ring, S5W, S5W, S, E, wv);
        if (l == 0 && cid >= (M / 256) * (S5W / 256)) { const Frame F = make_frame(ring, wv); deferred_l1(args, F, 1, (cid - (M / 256) * (S5W / 256)) * NWAVES + F.wave, (G - (M / 256) * (S5W / 256)) * NWAVES); }
    } else if (k == 6) {
        pg8::Seg3Sched S; S.T.init(M / 256, D / 256, G, cid); S.A = (const char*)(ws + WS_H); S.Bt = wl + WL_WBR; S.aStride = 256L * D * 2; S.bStride = 256L * D * 2;
        pg8::EpiBranch E{(const bf16_t*)(ws + WS_GATES), (bf16_t*)(ws + WS_MG)};
        pg8::gemm_phase<pg8::EpiBranch, pg8::Seg3Sched, true, true>(ring, D, D, S, E, wv);
    }
}

__global__ void __launch_bounds__(NWAVES * 64, 2) mk_fwd(Args args_by_value) {
    extern __shared__ __attribute__((aligned(16))) unsigned char lds_raw[];
    LAS unsigned char* lds = (LAS unsigned char*)lds_raw;
    KArgP args = (KArgP)__builtin_amdgcn_kernarg_segment_ptr();
    const int wv = __builtin_amdgcn_readfirstlane((int)threadIdx.x >> 6);
    {
        const int t0 = tid_of(wv);
        for (int u = t0; u < (LDS_BYTES - LDSCTL_OFF) / 4; u += NWAVES * 64) ((LAS unsigned*)(lds + LDSCTL_OFF))[u] = 0u;
        __syncthreads();
    }
    XcdBarrier bar; bar.bar = (unsigned*)(args->ws + WS_CTL) + CW_BAR; bar.x = 0; bar.st = nullptr;
#if !MK_PER_PHASE
    bar = xcd_barrier_post((unsigned*)(args->ws + WS_CTL) + CW_BAR, (volatile LAS unsigned*)(lds + MISC_OFF) + 8, wv);
#define GRID_BAR() do { xcd_barrier(bar, wv); if (REP_BAR) xcd_barrier(bar, wv); } while (0)
#else
#define GRID_BAR() do { } while (0)
#endif
    const int lo = args->ph_lo, hi = args->ph_hi;
    if (lo <= 0 && 0 < hi) {
        asm volatile("" : "+s"(args));
        p0_prologue(args, make_frame(lds, wv));
        if (1 < hi) GRID_BAR();
        if ((REP_MASK >> 13) & 1) { p0_prologue(args, make_frame(lds, wv), true); GRID_BAR(); }
    }
    if (lo <= 1 && 1 < hi) {
        asm volatile("" : "+s"(args));
        embed_phase(args, make_frame(lds, wv));
        if (2 < hi) GRID_BAR();
        if ((REP_MASK >> 14) & 1) { embed_phase(args, make_frame(lds, wv)); GRID_BAR(); }
    }
    for (int ph = (lo > PH_L0 ? lo : PH_L0); ph < (hi < N_PHASES - 1 ? hi : N_PHASES - 1); ++ph) {
        const int l = (ph - PH_L0) / PH_PER_LAYER, k = (ph - PH_L0) - l * PH_PER_LAYER;
        asm volatile("" : "+s"(args));
        layer_phase(args, l, k, lds, false, wv);
        if (ph + 1 < hi) GRID_BAR();
        if ((REP_MASK >> k) & 1) { asm volatile("" : "+s"(args)); layer_phase(args, l, k, lds, true, wv); GRID_BAR(); }
    }
    if (lo <= N_PHASES - 1 && N_PHASES - 1 < hi) {
        asm volatile("" : "+s"(args));
        final_phase(args, make_frame(lds, wv));
    }
#undef GRID_BAR
}

extern "C" void kernel_launch(void* const* d_in, const int* in_sizes, int n_in, void* d_out, int out_size, void* d_ws, size_t ws_size, hipStream_t stream) {
    static int grid = 0;
    if (grid == 0) {
        if (n_in != 35 || ws_size < WS_END) { fprintf(stderr, "kernel_launch: unexpected n_in %d or ws_size %zu (< %zu)\n", n_in, ws_size, (size_t)WS_END); grid = -1; return; }
        int dev = 0, cus = 0, per_cu = 0;
        if (hipGetDevice(&dev) != hipSuccess || hipDeviceGetAttribute(&cus, hipDeviceAttributeMultiprocessorCount, dev) != hipSuccess) { grid = -1; return; }
        if (hipFuncSetAttribute((const void*)mk_fwd, hipFuncAttributeMaxDynamicSharedMemorySize, LDS_BYTES) != hipSuccess) { fprintf(stderr, "kernel_launch: hipFuncSetAttribute failed\n"); grid = -1; return; }
        if (hipOccupancyMaxActiveBlocksPerMultiprocessor(&per_cu, (const void*)mk_fwd, NWAVES * 64, LDS_BYTES) != hipSuccess || per_cu < 1)
            fprintf(stderr, "kernel_launch: occupancy query reports %d workgroups per CU\n", per_cu);
        (void)hipGetLastError();
        grid = cus;
        if (grid != 256) fprintf(stderr, "kernel_launch: %d CUs (expected 256)\n", grid);
    }
    if (grid < 0) return;
    (void)hipMemsetAsync((char*)d_ws + WS_CTL, 0, CTL_ZERO_BYTES, stream);
    Args a{};
    for (int i = 0; i < 35; ++i) a.in[i] = (const float*)d_in[i];
    a.out = (float*)d_out; a.ws = (unsigned char*)d_ws;
#if MK_PER_PHASE
    for (int ph = 0; ph < N_PHASES; ++ph) { a.ph_lo = ph; a.ph_hi = ph + 1; hipLaunchKernelGGL(mk_fwd, dim3(grid), dim3(NWAVES * 64), LDS_BYTES, stream, a); }
#else
    a.ph_lo = 0; a.ph_hi = N_PHASES;
    hipLaunchKernelGGL(mk_fwd, dim3(grid), dim3(NWAVES * 64), LDS_BYTES, stream, a);
#endif
}
```

```cpp
#include <hip/hip_runtime.h>
#include <cstdio>
#include <cstdint>

#define LAS __attribute__((address_space(3)))
#define GAS __attribute__((address_space(1)))
typedef unsigned short bf16_t;
typedef short bf16x8 __attribute__((ext_vector_type(8)));
typedef float f32x4 __attribute__((ext_vector_type(4)));
typedef float f32x2 __attribute__((ext_vector_type(2)));
typedef float f32x16 __attribute__((ext_vector_type(16)));
typedef unsigned u32x4 __attribute__((ext_vector_type(4)));
typedef unsigned u32x2 __attribute__((ext_vector_type(2)));
typedef __bf16 bf16x2_t __attribute__((ext_vector_type(2)));
typedef GAS unsigned gu32;

#ifndef MK_PER_PHASE
#define MK_PER_PHASE 0
#endif
#ifndef REP_MASK
#define REP_MASK 0
#endif
#ifndef REP_BAR
#define REP_BAR 0
#endif
#ifndef REP0_PARTS
#define REP0_PARTS 15
#endif
#ifndef REP5_PARTS
#define REP5_PARTS 7
#endif

constexpr int D = 1024, MCTX = 8192, MSMP = 8192, M = 16384, CTXL = 256, SMPL = 1024, NCTXB = 32, NSMPB = 8, DEPTH = 2;
constexpr int DFF = 2816, S5W = 512, NG = 32, GH = 16, NP = 64, CW = 256, CK = 31, SGW = 256, SGC = 128, SGH = 4, SGD = 64, INC = 1536, NMOD = 9;
constexpr int NIN = 4608;
constexpr int TC = 16;
constexpr int YR = M / TC;
constexpr float EPS = 1e-6f;
constexpr int NWAVES = 8;

constexpr size_t MiB = 1u << 20;
constexpr size_t WS_CTL = 0, CTL_ZERO_BYTES = 3 * MiB;
constexpr size_t WS_MOD = 1 * MiB;
constexpr size_t WS_SSQ = 2 * MiB;
constexpr size_t WS_PE = 3 * MiB;
constexpr size_t WS_AT = 3 * MiB + 256 * 1024;
constexpr size_t WS_SHW = 4 * MiB;
constexpr int SHW_LD = 5632;
constexpr size_t WS_W = 6 * MiB;
constexpr size_t W1T_SZ = (size_t)2 * DFF * D * 2, W2T_SZ = (size_t)D * DFF * 2, WINT_SZ = (size_t)NIN * D * 2, WGLUT_SZ = (size_t)S5W * S5W * 2, WBRT_SZ = (size_t)D * D * 2, WOUTT_SZ = (size_t)D * D * 2;
constexpr size_t WL_W1 = 0, WL_W2 = 2 * W1T_SZ, WL_WIN = WL_W2 + 2 * W2T_SZ, WL_WGLU = WL_WIN + WINT_SZ, WL_WBR = WL_WGLU + WGLUT_SZ, WL_WOUT = WL_WBR + WBRT_SZ, WL_SZ = WL_WOUT + WOUTT_SZ;
static_assert(WL_SZ == (size_t)24379392 * 2, "weight bytes per layer");
constexpr size_t WS_KP = 100 * MiB;
constexpr size_t WS_PIN = 116 * MiB;
constexpr size_t WS_H = 124 * MiB;
constexpr size_t WS_HID = 156 * MiB;
constexpr size_t WS_YCAT = WS_HID;
constexpr size_t WS_CG = WS_HID + 32 * MiB;
constexpr size_t WS_SU = WS_HID + 40 * MiB;
constexpr size_t WS_SV = WS_HID + 48 * MiB;
constexpr size_t WS_YA = WS_HID + 56 * MiB;
constexpr size_t WS_SVST = WS_HID + 72 * MiB;
constexpr size_t WS_MG = WS_HID;
constexpr size_t WS_GATES = 244 * MiB;
constexpr size_t WS_END = 340 * MiB;
static_assert(WS_W + 2 * WL_SZ <= WS_KP && WS_HID + (size_t)M * DFF * 2 <= WS_GATES && WS_GATES + (size_t)M * 3 * D * 2 <= WS_END && WS_SHW + (size_t)6 * 9 * SHW_LD * 4 <= WS_W, "d_ws map");
constexpr int CW_TMO = 0, CW_BAR = 4096;

constexpr int RING_BYTES = 131072, LDSCTL_OFF = RING_BYTES, MISC_OFF = LDSCTL_OFF + 320, LDS_BYTES = 147456;
constexpr int STASH_OFF = RING_BYTES + 512, STASH_UNITS = 6;
static_assert(STASH_OFF + STASH_UNITS * 2048 <= LDS_BYTES, "LDS map");

#define RLX_AGENT __ATOMIC_RELAXED, __HIP_MEMORY_SCOPE_AGENT
#define LDS_WAIT() asm volatile("s_waitcnt lgkmcnt(0)" ::: "memory")
#define VM_WAIT() asm volatile("s_waitcnt vmcnt(0)" ::: "memory")
#ifndef WT_STORES
#define WT_STORES 0
#endif
__device__ __forceinline__ void st16(void* p, u32x4 v) {
#if WT_STORES
    asm volatile("global_store_dwordx4 %0, %1, off sc1\n\ts_nop 1" :: "v"(p), "v"(v) : "memory");
#else
    *(u32x4*)p = v;
#endif
}
__device__ __forceinline__ void st16f(void* p, f32x4 v) { st16(p, __builtin_bit_cast(u32x4, v)); }
__device__ __forceinline__ unsigned pk2(float lo, float hi) { f32x2 v = {lo, hi}; bf16x2_t b = __builtin_convertvector(v, bf16x2_t); return __builtin_bit_cast(unsigned, b); }
__device__ __forceinline__ float bflo(unsigned w) { return __uint_as_float(w << 16); }
__device__ __forceinline__ float bfhi(unsigned w) { return __uint_as_float(w & 0xffff0000u); }
__device__ __forceinline__ float bf1(bf16_t b) { return __uint_as_float((unsigned)b << 16); }
__device__ __forceinline__ float fast_sigmoid(float x) { return __builtin_amdgcn_rcpf(1.f + __expf(-x)); }
__device__ __forceinline__ float fast_silu(float x) { return x * fast_sigmoid(x); }
__device__ __forceinline__ float fast_gelu(float x) { const float u = 1.5957691216057308f * (x + 0.044715f * x * x * x); return x * fast_sigmoid(u); }
__device__ __forceinline__ float wave_sum(float v) {
#pragma unroll
    for (int o = 1; o < 64; o <<= 1) v += __shfl_xor(v, o);
    return v;
}
__device__ __forceinline__ int lane_id() { return (int)__builtin_amdgcn_mbcnt_hi(~0u, __builtin_amdgcn_mbcnt_lo(~0u, 0u)); }
__device__ __forceinline__ int tid_of(int wv) { return wv * 64 + lane_id(); }
__device__ __forceinline__ int cond_of_row(int row) { return row < MCTX ? 0 : 1 + ((row - MCTX) >> 10); }
__device__ __forceinline__ int cond_of_tile(int pm) { return pm < 32 ? 0 : 1 + ((pm - 32) >> 2); }

namespace pg8 {
constexpr int BM = 256, BK = 64, HALF = 128, HTB = HALF * BK * 2, NXCD = 8, WGM = 8;
__host__ __device__ __forceinline__ int lds_byte(int r, int c) { const int st = (r >> 4) * 2 + (c >> 5), rr = r & 15, cc = c & 31, ob = rr * 64 + cc * 2; return st * 1024 + (ob ^ (((ob >> 9) & 1) << 5)); }
__host__ __device__ __forceinline__ void stage_rc(int b, int& R, int& C) { const int st = b / 1024, sb = b % 1024, swz = sb ^ (((sb >> 9) & 1) << 5); R = (st >> 1) * 16 + swz / 64; C = (st & 1) * 32 + (swz % 64) / 2; }
__host__ __device__ __forceinline__ int perm32(int rho) { const int n = rho >> 4, i = rho & 15; return 8 * (i >> 2) + 4 * n + (i & 3); }

struct Unit { int pm, pn, nt, seg, idx; const char* a; const char* b; };
struct TileOrder {
    int nM, nN, nwg, G, c;
    __device__ __forceinline__ void init(int nM_, int nN_, int G_, int c_) { nM = nM_; nN = nN_; nwg = nM * nN; G = G_; c = c_; }
    __device__ __forceinline__ bool tile(int i, int& pm, int& pn) const {
        const long L = (long)i * G + c; if (L >= nwg) return false;
        int wgid = (int)L; { const int q = nwg / NXCD, r = nwg % NXCD, xcd = wgid % NXCD, off = wgid / NXCD; wgid = (xcd < r ? xcd * (q + 1) : r * (q + 1) + (xcd - r) * q) + off; }
        const int nig = WGM * nN, gid = wgid / nig, fm = gid * WGM, gsz = (nM - fm) < WGM ? (nM - fm) : WGM;
        pm = fm + ((wgid % nig) % gsz); pn = (wgid % nig) / gsz; return true;
    }
};
struct PlainSched {
    TileOrder T; const char* A; const char* Bt; long aStride, bStride, bgStride; int bgShift, nt;
    __device__ __forceinline__ bool next(int i, Unit& u) const {
        if (!T.tile(i, u.pm, u.pn)) return false;
        u.a = A + (long)u.pm * aStride; u.b = Bt + (long)u.pn * bStride + (long)(u.pm >> bgShift) * bgStride; u.nt = nt; u.seg = 0; return true; }
};
struct Seg3Sched {
    TileOrder T; const char* A; const char* Bt; long aStride, bStride;
    __device__ __forceinline__ bool next(int i, Unit& u) const {
        const int ti = i / 3, sg = i - 3 * ti;
        if (!T.tile(ti, u.pm, u.pn)) return false;
        const int koff = sg == 0 ? 0 : (sg == 1 ? 512 : 768);
        u.a = A + (long)u.pm * aStride + koff * 2; u.b = Bt + (long)u.pn * bStride + koff * 2; u.nt = sg == 0 ? 8 : 4; u.seg = sg; return true; }
};

typedef f32x4 Acc[2][2][4][2];

template <class Epi, class Sched, bool ALIGN_EPI, bool SP2>
__device__ __forceinline__ void gemm_phase(LAS unsigned char* lds, const int lda, const int ldb, const Sched& S, const Epi& E, const int wv) {
    int tid = tid_of(wv); asm volatile("" : "+v"(tid));
    const int wid = wv, lane = tid & 63, wr = wid >> 2, wc = wid & 3, fr = lane & 15, fq = lane >> 4;
    unsigned voffA[2], voffB[2];
#pragma unroll
    for (int i = 0; i < 2; ++i) { int R, C; stage_rc(tid * 16 + i * 8192, R, C); const int Rb = Epi::PERM ? ((R & ~31) + perm32(R & 31)) : R;
        voffA[i] = (unsigned)(R * lda + C) * 2u; voffB[i] = (unsigned)(Rb * ldb + C) * 2u; }
    const size_t kstep = (size_t)(BK * 2);
    const size_t hstepA = (size_t)HALF * lda * 2, hstepB = (size_t)HALF * ldb * 2;
    const unsigned ldsw = (unsigned)wid * 1024u;
    const int aoff = lds_byte(wr * 64 + fr, fq * 8), boff = lds_byte(wc * 32 + fr, fq * 8);
#define PG8_SA(b, h) (((b) * 2 + (h)) * HTB)
#define PG8_SB(b, h) ((4 + (b) * 2 + (h)) * HTB)
#define PG8_STAGE(bufoff, gbase, voff) do { _Pragma("unroll") for (int _i = 0; _i < 2; ++_i) \
        __builtin_amdgcn_global_load_lds((const unsigned*)((const char*)(gbase) + (voff)[_i]), (LAS unsigned*)(lds + (bufoff) + ldsw + _i * 8192), 16, 0, 0); } while (0)
#define PG8_LDA(dst, b, h) do { _Pragma("unroll") for (int m = 0; m < 4; ++m) _Pragma("unroll") for (int k = 0; k < 2; ++k) dst[m][k] = *(const LAS bf16x8*)(lds + PG8_SA(b, h) + aoff + m * 2048 + k * 1024); } while (0)
#define PG8_LDB(dst, b, h) do { _Pragma("unroll") for (int n = 0; n < 2; ++n) _Pragma("unroll") for (int k = 0; k < 2; ++k) dst[n][k] = *(const LAS bf16x8*)(lds + PG8_SB(b, h) + boff + n * 2048 + k * 1024); } while (0)
#define PG8_MMA(ai, bj, At, Bt) do { __builtin_amdgcn_s_setprio(1); _Pragma("unroll") for (int m = 0; m < 4; ++m) _Pragma("unroll") for (int n = 0; n < 2; ++n) _Pragma("unroll") for (int k = 0; k < 2; ++k) \
        acc[ai][bj][m][n] = __builtin_amdgcn_mfma_f32_16x16x32_bf16(Bt[n][k], At[m][k], acc[ai][bj][m][n], 0, 0, 0); __builtin_amdgcn_s_setprio(0); } while (0)
#define PG8_WAIT_V(n) asm volatile("s_waitcnt vmcnt(" #n ")" ::: "memory")
#define PG8_WAIT_L(n) asm volatile("s_waitcnt lgkmcnt(" #n ")" ::: "memory")
#define PG8_BAR __builtin_amdgcn_s_barrier()
#define PG8_SCHED __builtin_amdgcn_sched_barrier(0)
    Unit cur, nxt; int ui = 0;
    if (!S.next(0, cur)) return;
    cur.idx = 0;
    Acc acc;
#pragma unroll
    for (int a = 0; a < 2; ++a)
#pragma unroll
        for (int b = 0; b < 2; ++b)
#pragma unroll
            for (int m = 0; m < 4; ++m)
#pragma unroll
                for (int n = 0; n < 2; ++n) acc[a][b][m][n] = (f32x4){0.f, 0.f, 0.f, 0.f};
    bf16x8 At[4][2], B0[2][2], B1[2][2];
    const char* cA = cur.a; const char* cB = cur.b;
    if constexpr (SP2) {
        PG8_STAGE(PG8_SB(0, 0), cB, voffB); PG8_STAGE(PG8_SB(0, 1), cB + hstepB, voffB); PG8_STAGE(PG8_SA(0, 0), cA, voffA); PG8_STAGE(PG8_SA(0, 1), cA + hstepA, voffA);
        if (wr == 1) PG8_BAR;
        PG8_WAIT_V(2); PG8_BAR;
        PG8_STAGE(PG8_SB(1, 0), cB + kstep, voffB); PG8_STAGE(PG8_SA(1, 0), cA + kstep, voffA); PG8_STAGE(PG8_SB(1, 1), cB + hstepB + kstep, voffB);
        PG8_WAIT_V(6); PG8_BAR;
    } else {
        PG8_STAGE(PG8_SB(0, 0), cB, voffB); PG8_STAGE(PG8_SA(0, 0), cA, voffA); PG8_STAGE(PG8_SB(0, 1), cB + hstepB, voffB); PG8_STAGE(PG8_SA(0, 1), cA + hstepA, voffA);
        if (wr == 1) PG8_BAR;
        PG8_WAIT_V(4); PG8_BAR;
        PG8_STAGE(PG8_SB(1, 0), cB + kstep, voffB); PG8_STAGE(PG8_SA(1, 0), cA + kstep, voffA); PG8_STAGE(PG8_SB(1, 1), cB + hstepB + kstep, voffB);
        PG8_WAIT_V(6); PG8_BAR;
    }
    for (;;) {
        const bool has_next = S.next(ui + 1, nxt); nxt.idx = ui + 1;
        const char* nA = has_next ? nxt.a : cA; const char* nB = has_next ? nxt.b : cB;
        const int nt = cur.nt;
        for (int t = 0; t < nt; t += 2) {
            const bool last = (t == nt - 2);
            const char* a1 = cA + (size_t)(t + 1) * kstep;
            const char* a2 = last ? nA : cA + (size_t)(t + 2) * kstep; const char* b2 = last ? nB : cB + (size_t)(t + 2) * kstep;
            const char* a3 = a2 + kstep; const char* b3 = b2 + kstep;
            if constexpr (SP2) {
            PG8_LDB(B0, 0, 0); PG8_LDB(B1, 0, 1); PG8_SCHED; PG8_LDA(At, 0, 0); PG8_STAGE(PG8_SA(1, 1), a1 + hstepA, voffA);
            PG8_WAIT_V(8); PG8_WAIT_L(0); PG8_BAR; PG8_MMA(0, 0, At, B0); PG8_MMA(0, 1, At, B1); PG8_BAR; PG8_SCHED;
            PG8_LDA(At, 0, 1); PG8_STAGE(PG8_SB(0, 0), b2, voffB); PG8_STAGE(PG8_SB(0, 1), b2 + hstepB, voffB); PG8_STAGE(PG8_SA(0, 0), a2, voffA);
            PG8_WAIT_V(8); PG8_WAIT_L(0); PG8_BAR; PG8_MMA(1, 0, At, B0); PG8_MMA(1, 1, At, B1); PG8_BAR; PG8_SCHED;
            PG8_LDB(B0, 1, 0); PG8_LDB(B1, 1, 1); PG8_SCHED; PG8_LDA(At, 1, 0); PG8_STAGE(PG8_SA(0, 1), a2 + hstepA, voffA);
            PG8_WAIT_V(8); PG8_WAIT_L(0); PG8_BAR; PG8_MMA(0, 0, At, B0); PG8_MMA(0, 1, At, B1); PG8_BAR; PG8_SCHED;
            PG8_LDA(At, 1, 1); PG8_STAGE(PG8_SB(1, 0), b3, voffB); PG8_STAGE(PG8_SB(1, 1), b3 + hstepB, voffB); PG8_STAGE(PG8_SA(1, 0), a3, voffA);
            PG8_WAIT_V(8); PG8_WAIT_L(0); PG8_BAR; PG8_MMA(1, 0, At, B0); PG8_MMA(1, 1, At, B1); PG8_BAR; PG8_SCHED;
            } else {
            PG8_LDB(B0, 0, 0); PG8_SCHED; PG8_LDA(At, 0, 0); PG8_STAGE(PG8_SA(1, 1), a1 + hstepA, voffA);
            PG8_WAIT_L(8); PG8_BAR; PG8_WAIT_L(0); PG8_MMA(0, 0, At, B0); PG8_BAR; PG8_SCHED;
            PG8_LDB(B1, 0, 1); PG8_STAGE(PG8_SB(0, 0), b2, voffB);
            PG8_BAR; PG8_WAIT_L(0); PG8_MMA(0, 1, At, B1); PG8_BAR;
            PG8_LDA(At, 0, 1); PG8_STAGE(PG8_SA(0, 0), a2, voffA);
            PG8_BAR; PG8_WAIT_L(0); PG8_MMA(1, 0, At, B0); PG8_BAR; PG8_SCHED;
            PG8_STAGE(PG8_SB(0, 1), b2 + hstepB, voffB);
            PG8_WAIT_V(6); PG8_BAR; PG8_MMA(1, 1, At, B1); PG8_BAR;
            PG8_LDB(B0, 1, 0); PG8_SCHED; PG8_LDA(At, 1, 0); PG8_STAGE(PG8_SA(0, 1), a2 + hstepA, voffA);
            PG8_WAIT_L(8); PG8_BAR; PG8_WAIT_L(0); PG8_MMA(0, 0, At, B0); PG8_BAR; PG8_SCHED;
            PG8_LDB(B1, 1, 1); PG8_STAGE(PG8_SB(1, 0), b3, voffB);
            PG8_BAR; PG8_WAIT_L(0); PG8_MMA(0, 1, At, B1); PG8_BAR;
            PG8_LDA(At, 1, 1); PG8_STAGE(PG8_SA(1, 0), a3, voffA);
            PG8_BAR; PG8_WAIT_L(0); PG8_MMA(1, 0, At, B0); PG8_BAR; PG8_SCHED;
            PG8_STAGE(PG8_SB(1, 1), b3 + hstepB, voffB);
            PG8_WAIT_V(6); PG8_BAR; PG8_MMA(1, 1, At, B1); PG8_BAR;
            }
        }
        if constexpr (ALIGN_EPI) { if (wr == 0) PG8_BAR; }
        bool keep = false;
        if constexpr (!Epi::AFTER_DRAIN) { keep = E(acc, cur, wr, wc, fr, fq); }
        if (!has_next) break;
        if (!keep) {
#pragma unroll
        for (int a = 0; a < 2; ++a)
#pragma unroll
            for (int b = 0; b < 2; ++b)
#pragma unroll
                for (int m = 0; m < 4; ++m)
#pragma unroll
                    for (int n = 0; n < 2; ++n) acc[a][b][m][n] = (f32x4){0.f, 0.f, 0.f, 0.f};
        }
        cur = nxt; cA = nA; cB = nB; ++ui;
        if constexpr (ALIGN_EPI) { if (wr == 1) PG8_BAR; }
    }
    PG8_WAIT_V(0);
    if constexpr (!ALIGN_EPI) { if (wr == 0) PG8_BAR; }
    PG8_BAR;
    if constexpr (Epi::AFTER_DRAIN) { E.fused(acc, cur, wr, wc, fr, fq, lds, wid, lane); }
#undef PG8_SA
#undef PG8_SB
#undef PG8_STAGE
#undef PG8_LDA
#undef PG8_LDB
#undef PG8_MMA
#undef PG8_WAIT_V
#undef PG8_WAIT_L
#undef PG8_BAR
#undef PG8_SCHED
}

struct Stash { const LAS float* r; const LAS float* s; };
struct EpiSwiGLU {
    static constexpr bool PERM = true, AFTER_DRAIN = false;
    bf16_t* hid; Stash st;
    __device__ __forceinline__ bool operator()(Acc& acc, const Unit& u, int wr, int wc, int fr, int fq) const {
        const unsigned off0 = (unsigned)(u.pm * BM + wr * 64 + fr) * DFF + u.pn * 128 + wc * 32 + 8 * fq;
        const LAS float* sp = st.s + u.idx * 256 + wc * 32 + 8 * fq; const LAS float* rp = st.r + u.idx * 256 + wr * 64 + fr;
#pragma unroll
        for (int ai = 0; ai < 2; ++ai)
#pragma unroll
            for (int m = 0; m < 4; ++m) {
                const float r = rp[ai * HALF + m * 16];
                const f32x4 sg0 = *(const LAS f32x4*)(sp), sg1 = *(const LAS f32x4*)(sp + 4), su0 = *(const LAS f32x4*)(sp + 128), su1 = *(const LAS f32x4*)(sp + 132);
                const f32x4 g0 = acc[ai][0][m][0] * r + sg0, g1 = acc[ai][0][m][1] * r + sg1, u0 = acc[ai][1][m][0] * r + su0, u1 = acc[ai][1][m][1] * r + su1;
                u32x4 w;
                w.x = pk2(fast_silu(g0[0]) * u0[0], fast_silu(g0[1]) * u0[1]); w.y = pk2(fast_silu(g0[2]) * u0[2], fast_silu(g0[3]) * u0[3]);
                w.z = pk2(fast_silu(g1[0]) * u1[0], fast_silu(g1[1]) * u1[1]); w.w = pk2(fast_silu(g1[2]) * u1[2], fast_silu(g1[3]) * u1[3]);
                st16(hid + (off0 + (unsigned)(ai * HALF + m * 16) * DFF), w);
                asm volatile("" ::: "memory");
            }
        return false;
    }
};
struct EpiResid {
    static constexpr bool PERM = true, AFTER_DRAIN = false;
    const bf16_t* Xin; bf16_t* Xout; float* Xf; const float* modl; int sub; float scale;
    bf16_t* xb; const float* gnext; const float* modn; int subn; float* ssq;
    __device__ __forceinline__ bool operator()(Acc& acc, const Unit& u, int wr, int wc, int fr, int fq) const {
        const unsigned row0 = u.pm * BM + wr * 64 + fr, col0 = u.pn * BM + wc * 32 + 8 * fq;
        const unsigned cond = cond_of_tile(u.pm);
        const unsigned goff = cond * (NMOD * D) + (3 * sub + 2) * D + col0, noff = cond * (NMOD * D) + (3 * subn + 1) * D + col0;
        const bool nx = xb != nullptr, fin = Xf != nullptr;
        float ss[8];
#pragma unroll
        for (int i = 0; i < 8; ++i) ss[i] = 0.f;
#pragma unroll
        for (int bj = 0; bj < 2; ++bj) {
            const f32x4 gv0 = *(const f32x4*)(modl + goff + bj * HALF) * scale, gv1 = *(const f32x4*)(modl + goff + bj * HALF + 4) * scale;
            f32x4 G0 = (f32x4){0.f, 0.f, 0.f, 0.f}, G1 = G0;
            if (nx) { G0 = *(const f32x4*)(gnext + col0 + bj * HALF) * (*(const f32x4*)(modn + noff + bj * HALF) + 1.f); G1 = *(const f32x4*)(gnext + col0 + bj * HALF + 4) * (*(const f32x4*)(modn + noff + bj * HALF + 4) + 1.f); }
#pragma unroll
            for (int ai = 0; ai < 2; ++ai)
#pragma unroll
                for (int m = 0; m < 4; ++m) {
                    const unsigned eoff = (row0 + ai * HALF + m * 16) * D + col0 + bj * HALF;
                    const u32x4 xi = *(const u32x4*)(Xin + eoff);
                    f32x4 x0 = (f32x4){bflo(xi.x), bfhi(xi.x), bflo(xi.y), bfhi(xi.y)}, x1 = (f32x4){bflo(xi.z), bfhi(xi.z), bflo(xi.w), bfhi(xi.w)};
                    x0 = x0 + gv0 * acc[ai][bj][m][0]; x1 = x1 + gv1 * acc[ai][bj][m][1];
                    if (fin) { *(f32x4*)(Xf + eoff) = x0; *(f32x4*)(Xf + eoff + 4) = x1; }
                    else { u32x4 w; w.x = pk2(x0[0], x0[1]); w.y = pk2(x0[2], x0[3]); w.z = pk2(x1[0], x1[1]); w.w = pk2(x1[2], x1[3]); st16(Xout + eoff, w); }
                    if (nx) {
                        ss[ai * 4 + m] += ((x0[0] * x0[0] + x0[1] * x0[1]) + (x0[2] * x0[2] + x0[3] * x0[3])) + ((x1[0] * x1[0] + x1[1] * x1[1]) + (x1[2] * x1[2] + x1[3] * x1[3]));
                        const f32x4 b0 = x0 * G0, b1 = x1 * G1;
                        u32x4 w; w.x = pk2(b0[0], b0[1]); w.y = pk2(b0[2], b0[3]); w.z = pk2(b1[0], b1[1]); w.w = pk2(b1[2], b1[3]);
                        st16(xb + eoff, w); }
                    if (m & 1) asm volatile("" ::: "memory");
                }
        }
        if (nx) {
#pragma unroll
            for (int i = 0; i < 8; ++i) { float v = ss[i]; v += __shfl_xor(v, 16); v += __shfl_xor(v, 32); if (fq == 0) atomicAdd(ssq + row0 + (i >> 2) * HALF + (i & 3) * 16, v); }
        }
        return false;
    }
};
struct EpiMixIn {
    static constexpr bool PERM = true, AFTER_DRAIN = false;
    bf16_t* ycat; bf16_t* cg; bf16_t* su; bf16_t* sv; bf16_t* gates; float* svst; Stash st;
    __device__ __forceinline__ bool operator()(Acc& acc, const Unit& u, int wr, int wc, int fr, int fq) const {
        const int row0 = u.pm * BM + wr * 64 + fr;
        const int pn = u.pn;
        const LAS float* sp = st.s + u.idx * 256 + wc * 32 + 8 * fq; const LAS float* rp = st.r + u.idx * 256 + wr * 64 + fr;
#pragma unroll
        for (int ai = 0; ai < 2; ++ai)
#pragma unroll
            for (int m = 0; m < 4; ++m) {
                const float r = rp[ai * HALF + m * 16];
                const size_t row = row0 + ai * HALF + m * 16;
                f32x4 z[2][2];
#pragma unroll
                for (int bj = 0; bj < 2; ++bj)
#pragma unroll
                    for (int n = 0; n < 2; ++n) z[bj][n] = acc[ai][bj][m][n] * r + *(const LAS f32x4*)(sp + bj * 128 + 4 * n);
                if (pn < 2) {
#pragma unroll
                    for (int bj = 0; bj < 2; ++bj) {
                        const int g = 16 * pn + 8 * bj + 2 * wc + (fq >> 1), h0 = 8 * (fq & 1);
                        const int rr = 16 * u.pm + 8 * ai + 4 * wr + m;
                        u32x4 w; w.x = pk2(z[bj][0][0], z[bj][0][1]); w.y = pk2(z[bj][0][2], z[bj][0][3]); w.z = pk2(z[bj][1][0], z[bj][1][1]); w.w = pk2(z[bj][1][2], z[bj][1][3]);
                        st16(ycat + ((size_t)(g * YR + rr) * 512 + fr * 16 + h0), w);
                    }
                } else if (pn < 4) {
                    u32x4 w;
                    w.x = pk2(z[0][0][0] * fast_sigmoid(z[1][0][0]), z[0][0][1] * fast_sigmoid(z[1][0][1])); w.y = pk2(z[0][0][2] * fast_sigmoid(z[1][0][2]), z[0][0][3] * fast_sigmoid(z[1][0][3]));
                    w.z = pk2(z[0][1][0] * fast_sigmoid(z[1][1][0]), z[0][1][1] * fast_sigmoid(z[1][1][1])); w.w = pk2(z[0][1][2] * fast_sigmoid(z[1][1][2]), z[0][1][3] * fast_sigmoid(z[1][1][3]));
                    st16(cg + row * CW + (pn - 2) * 128 + wc * 32 + 8 * fq, w);
                } else if (pn < 6) {
                    bf16_t* dst = pn == 4 ? su : sv;
                    float s1 = 0.f, s2 = 0.f;
#pragma unroll
                    for (int bj = 0; bj < 2; ++bj) {
                        f32x4 g0, g1;
#pragma unroll
                        for (int e = 0; e < 4; ++e) { g0[e] = fast_gelu(z[bj][0][e]); g1[e] = fast_gelu(z[bj][1][e]); }
                        s1 += ((g0[0] + g0[1]) + (g0[2] + g0[3])) + ((g1[0] + g1[1]) + (g1[2] + g1[3]));
                        s2 += ((g0[0] * g0[0] + g0[1] * g0[1]) + (g0[2] * g0[2] + g0[3] * g0[3])) + ((g1[0] * g1[0] + g1[1] * g1[1]) + (g1[2] * g1[2] + g1[3] * g1[3]));
                        u32x4 w; w.x = pk2(g0[0], g0[1]); w.y = pk2(g0[2], g0[3]); w.z = pk2(g1[0], g1[1]); w.w = pk2(g1[2], g1[3]);
                        st16(dst + row * SGW + bj * HALF + wc * 32 + 8 * fq, w);
                    }
                    if (pn == 5) { s1 += __shfl_xor(s1, 16); s1 += __shfl_xor(s1, 32); s2 += __shfl_xor(s2, 16); s2 += __shfl_xor(s2, 32);
                        if (fq == 0) *(f32x2*)(svst + (row * 4 + wc) * 2) = (f32x2){s1, s2}; }
                } else {
#pragma unroll
                    for (int bj = 0; bj < 2; ++bj) {
                        u32x4 w; w.x = pk2(fast_sigmoid(z[bj][0][0]), fast_sigmoid(z[bj][0][1])); w.y = pk2(fast_sigmoid(z[bj][0][2]), fast_sigmoid(z[bj][0][3]));
                        w.z = pk2(fast_sigmoid(z[bj][1][0]), fast_sigmoid(z[bj][1][1])); w.w = pk2(fast_sigmoid(z[bj][1][2]), fast_sigmoid(z[bj][1][3]));
                        st16(gates + row * (3 * D) + (pn - 6) * BM + wc * 32 + 8 * fq + bj * HALF, w);
                    }
                }
            }
        return false;
    }
};
struct EpiS5X {
    static constexpr bool PERM = false, AFTER_DRAIN = true;
    bf16_t* ycat; const float* aT; const float* state_in; float* state_out; int l;
    __device__ __forceinline__ bool operator()(Acc&, const Unit&, int, int, int, int) const { return false; }
    __device__ __forceinline__ void fused(Acc& acc, const Unit& u, int wr, int wc, int fr, int fq, LAS unsigned char* lds, int wid, int lane) const {
        const int g = u.pm >> 2, quarter = u.pm & 3; const bool is_ctx = quarter < 2;
        LAS float* XS = (LAS float*)lds;
        const int p = lane;
#pragma unroll
        for (int dir = 0; dir < 2; ++dir) {
            __syncthreads();
#pragma unroll
            for (int ai = 0; ai < 2; ++ai)
#pragma unroll
                for (int m = 0; m < 4; ++m)
#pragma unroll
                    for (int n = 0; n < 2; ++n) { const int row = 128 * ai + 64 * wr + 16 * m + fr, col = 32 * wc + 16 * n + 4 * fq;
                        *(LAS f32x4*)(XS + row * 128 + (col ^ ((row & 7) << 2))) = acc[ai][dir][m][n]; }
            __syncthreads();
            const f32x2 at = *(const f32x2*)(aT + ((size_t)(dir * NG + g) * NP + p) * 2);
            int nseq, rows_per_seq, row_first; long bbase;
            if (is_ctx) { nseq = 2; rows_per_seq = 16; row_first = 32 * wid; bbase = quarter * 16 + 2 * wid; }
            else { nseq = wid < 4 ? 1 : 0; rows_per_seq = 64; row_first = 64 * wid; bbase = (quarter - 2) * 4 + wid; }
            for (int s = 0; s < nseq; ++s) {
                const long b = bbase + s;
                const size_t so = ((((size_t)b * DEPTH + l) * 2 + dir) * NG + g) * NP + p;
                float sr = 0.f, si = 0.f;
                if (!is_ctx) { const f32x2 h0 = *(const f32x2*)(state_in + so * 2); sr = h0.x; si = h0.y; }
                const int r0 = row_first + s * rows_per_seq;
                for (int q = 0; q < rows_per_seq; ++q) {
                    const int row = dir == 0 ? r0 + q : r0 + rows_per_seq - 1 - q;
                    const int sw = (row & 7) << 2;
                    const float xr = XS[row * 128 + (p ^ sw)], xi = XS[row * 128 + ((64 + p) ^ sw)];
                    bf16_t* dst = ycat + ((size_t)(g * YR + quarter * 256 + row) * 512 + 256 + dir * 128 + p);
                    const unsigned pr = pk2(sr, si);
                    dst[0] = (bf16_t)(pr & 0xffffu); dst[64] = (bf16_t)(pr >> 16);
                    const float nsr = at.x * sr - at.y * si + xr, nsi = at.x * si + at.y * sr + xi;
                    sr = nsr; si = nsi;
                }
                if (is_ctx) *(f32x2*)(state_out + so * 2) = (f32x2){sr, si};
            }
        }
    }
};
struct EpiS5Y {
    static constexpr bool PERM = true, AFTER_DRAIN = false;
    bf16_t* ya;
    __device__ __forceinline__ bool operator()(Acc& acc, const Unit& u, int wr, int wc, int fr, int fq) const {
        const int g = u.pm >> 2, rr0 = (u.pm & 3) * 256 + 64 * wr + fr;
#pragma unroll
        for (int ai = 0; ai < 2; ++ai)
#pragma unroll
            for (int m = 0; m < 4; ++m)
#pragma unroll
                for (int bj = 0; bj < 2; ++bj) {
                    const int rr = rr0 + 128 * ai + 16 * m, i = 8 * bj + 2 * wc + (fq >> 1), h0 = 8 * (fq & 1), tok = rr * TC + i;
                    const f32x4 v0 = acc[ai][bj][m][0], v1 = acc[ai][bj][m][1];
                    u32x4 w; w.x = pk2(fast_gelu(v0[0]), fast_gelu(v0[1])); w.y = pk2(fast_gelu(v0[2]), fast_gelu(v0[3])); w.z = pk2(fast_gelu(v1[0]), fast_gelu(v1[1])); w.w = pk2(fast_gelu(v1[2]), fast_gelu(v1[3]));
                    st16(ya + (size_t)tok * S5W + g * GH + h0, w);
                }
        return false;
    }
};
struct EpiGlu {
    static constexpr bool PERM = true, AFTER_DRAIN = false;
    const bf16_t* ya; bf16_t* yc;
    __device__ __forceinline__ bool operator()(Acc& acc, const Unit& u, int wr, int wc, int fr, int fq) const {
        const int row0 = u.pm * BM + wr * 64 + fr, col0 = u.pn * BM + wc * 32 + 8 * fq;
#pragma unroll
        for (int ai = 0; ai < 2; ++ai)
#pragma unroll
            for (int m = 0; m < 4; ++m)
#pragma unroll
                for (int bj = 0; bj < 2; ++bj) {
                    const size_t row = row0 + ai * HALF + m * 16; const int col = col0 + bj * HALF;
                    const u32x4 y = *(const u32x4*)(ya + row * S5W + col);
                    const f32x4 v0 = acc[ai][bj][m][0], v1 = acc[ai][bj][m][1];
                    u32x4 w;
                    w.x = pk2(bflo(y.x) * fast_sigmoid(v0[0]), bfhi(y.x) * fast_sigmoid(v0[1])); w.y = pk2(bflo(y.y) * fast_sigmoid(v0[2]), bfhi(y.y) * fast_sigmoid(v0[3]));
                    w.z = pk2(bflo(y.z) * fast_sigmoid(v1[0]), bfhi(y.z) * fast_sigmoid(v1[1])); w.w = pk2(bflo(y.w) * fast_sigmoid(v1[2]), bfhi(y.w) * fast_sigmoid(v1[3]));
                    st16(yc + row * D + col, w);
                }
        return false;
    }
};
struct EpiBranch {
    static constexpr bool PERM = true, AFTER_DRAIN = false;
    const bf16_t* gates; bf16_t* mg;
    __device__ __forceinline__ bool operator()(Acc& acc, const Unit& u, int wr, int wc, int fr, int fq) const {
        const int row0 = u.pm * BM + wr * 64 + fr, col0 = u.pn * BM + wc * 32 + 8 * fq;
        const int seg = u.seg;
#pragma unroll
        for (int ai = 0; ai < 2; ++ai)
#pragma unroll
            for (int m = 0; m < 4; ++m)
#pragma unroll
                for (int bj = 0; bj < 2; ++bj) {
                    const size_t row = row0 + ai * HALF + m * 16; const int col = col0 + bj * HALF;
                    const bf16_t* gp = gates + row * (3 * D) + col;
                    f32x4& v0 = acc[ai][bj][m][0]; f32x4& v1 = acc[ai][bj][m][1];
                    if (seg < 2) {
                        const u32x4 gn = *(const u32x4*)(gp + seg * D), gd = *(const u32x4*)(gp + (seg + 1) * D);
                        v0[0] *= bflo(gn.x) * __builtin_amdgcn_rcpf(bflo(gd.x)); v0[1] *= bfhi(gn.x) * __builtin_amdgcn_rcpf(bfhi(gd.x));
                        v0[2] *= bflo(gn.y) * __builtin_amdgcn_rcpf(bflo(gd.y)); v0[3] *= bfhi(gn.y) * __builtin_amdgcn_rcpf(bfhi(gd.y));
                        v1[0] *= bflo(gn.z) * __builtin_amdgcn_rcpf(bflo(gd.z)); v1[1] *= bfhi(gn.z) * __builtin_amdgcn_rcpf(bfhi(gd.z));
                        v1[2] *= bflo(gn.w) * __builtin_amdgcn_rcpf(bflo(gd.w)); v1[3] *= bfhi(gn.w) * __builtin_amdgcn_rcpf(bfhi(gd.w));
                    } else {
                        const u32x4 gc = *(const u32x4*)(gp + 2 * D);
                        u32x4 w;
                        w.x = pk2(v0[0] * bflo(gc.x), v0[1] * bfhi(gc.x)); w.y = pk2(v0[2] * bflo(gc.y), v0[3] * bfhi(gc.y));
                        w.z = pk2(v1[0] * bflo(gc.z), v1[1] * bfhi(gc.z)); w.w = pk2(v1[2] * bflo(gc.w), v1[3] * bfhi(gc.w));
                        st16(mg + row * D + col, w);
                    }
                }
        return seg < 2;
    }
};
}

#define XB_TMO      128
#define XB_XCNT(j)  (256  + 64 * (j))
#define XB_XSUB(j)  (1280 + 64 * (j))
#define XB_XGEN(j)  (2304 + 64 * (j))
#define XB_TOP      3328
#define XB_TOPGEN   3392
#define XCD_BAR_WORDS 3456
#define XB_SPIN_CAP (1u << 18)
__device__ __forceinline__ unsigned xb_ld(unsigned* p)              { return __hip_atomic_load(p, __ATOMIC_RELAXED, __HIP_MEMORY_SCOPE_AGENT); }
__device__ __forceinline__ unsigned xb_add(unsigned* p, unsigned v) { return __hip_atomic_fetch_add(p, v, __ATOMIC_RELAXED, __HIP_MEMORY_SCOPE_AGENT); }
__device__ __forceinline__ unsigned xb_xcc_id() { return (unsigned)__builtin_amdgcn_s_getreg((3 << 11) | 20) & 0xFu; }
#define XB_SPIN(cond, bar) do { unsigned _sp = 0; while (cond) { __builtin_amdgcn_s_sleep(1); \
    if ((++_sp & 255u) == 0u) { if (xb_ld(&(bar)[XB_TMO])) break; if (_sp > XB_SPIN_CAP) { atomicAdd(&(bar)[XB_TMO], 1u); break; } } } } while (0)
struct XcdBarrier { unsigned* bar; unsigned x; volatile LAS unsigned* st; };
__device__ __forceinline__ XcdBarrier xcd_barrier_post(unsigned* bar, volatile LAS unsigned* st, const int wv) {
    XcdBarrier b; b.bar = bar; b.x = xb_xcc_id(); b.st = st;
    if (tid_of(wv) == 0) (void)xb_add(&bar[XB_XCNT(b.x)], 1u);
    return b;
}
__device__ __forceinline__ void xcd_barrier_complete(unsigned* bar, unsigned x, unsigned& nloc, unsigned& nx) {
    const unsigned G = gridDim.x * gridDim.y * gridDim.z;
    unsigned sum, cnt, mine, sp = 0u;
    for (;;) {
        sum = 0u; cnt = 0u; mine = 0u;
#pragma unroll
        for (unsigned j = 0; j < 16; ++j) { const unsigned c = xb_ld(&bar[XB_XCNT(j)]); sum += c; cnt += (c > 0u) ? 1u : 0u; mine = (j == x) ? c : mine; }
        if (sum == G) break;
        __builtin_amdgcn_s_sleep(1);
        if ((++sp & 255u) == 0u) { if (xb_ld(&bar[XB_TMO])) break; if (sp > XB_SPIN_CAP) { atomicAdd(&bar[XB_TMO], 1u); break; } }
    }
    nloc = mine > 0u ? mine : 1u; nx = cnt > 0u ? cnt : 1u;
}
__device__ __forceinline__ void xcd_barrier(const XcdBarrier& b, const int wv) {
    asm volatile("s_waitcnt vmcnt(0)" ::: "memory");
    __syncthreads();
    if (tid_of(wv) == 0) {
        unsigned* bar = b.bar;
        __builtin_amdgcn_s_waitcnt(0);
        unsigned nloc = b.st[0], nx = b.st[1];
        if (nloc == 0u) { xcd_barrier_complete(bar, b.x, nloc, nx); b.st[0] = nloc; b.st[1] = nx; }
        const unsigned old = xb_add(&bar[XB_XSUB(b.x)], 1u);
        const unsigned gen = old / nloc;
        if (old + 1u == (gen + 1u) * nloc) {
            __builtin_amdgcn_fence(__ATOMIC_RELEASE, "agent");
            asm volatile("s_waitcnt vmcnt(0)" ::: "memory");
            const unsigned og = xb_add(&bar[XB_TOP], 1u);
            const unsigned tg = og / nx;
            if (og + 1u == (tg + 1u) * nx) xb_add(&bar[XB_TOPGEN], 1u);
            else XB_SPIN(xb_ld(&bar[XB_TOPGEN]) == tg, bar);
            __builtin_amdgcn_fence(__ATOMIC_ACQUIRE, "agent");
            xb_add(&bar[XB_XGEN(b.x)], 1u);
            asm volatile("s_waitcnt vmcnt(0)" ::: "memory");
        } else {
            XB_SPIN(xb_ld(&bar[XB_XGEN(b.x)]) == gen, bar);
            __builtin_amdgcn_fence(__ATOMIC_ACQUIRE, "agent");
            asm volatile("s_waitcnt vmcnt(0)" ::: "memory");
        }
    }
    __syncthreads();
}

struct Args { const float* in[35]; float* out; unsigned char* ws; int ph_lo, ph_hi; };
typedef const __attribute__((address_space(4))) Args* KArgP;
struct Frame {
    LAS unsigned char* lds; volatile LAS unsigned* MISC;
    int tid, lane, wave, vcu, G;
};
enum { I_XP = 0, I_XS, I_STATE, I_C, I_CCTX, I_WMOD, I_BMOD, I_NORMG, I_W1, I_W2, I_WIN, I_WGATE, I_BGATE, I_ARE, I_AIM, I_LOGDT, I_BRE, I_BIM, I_CRE, I_CIM, I_S5D, I_WGLU, I_WBRA,
       I_CONVW, I_CONVB, I_CLNG, I_CLNB, I_WBRB, I_SGLNG, I_SGLNB, I_SGW, I_SGB, I_WBRC, I_WOUT, I_FINALG };

__device__ __forceinline__ void p0_transpose_item(const float* src, int srcLd, bf16_t* dst, int dstLd, LAS float* scr, int lane) {
    const int r8 = lane >> 3, c4 = (lane & 7) * 4;
    f32x4 v[8];
#pragma unroll
    for (int i = 0; i < 8; ++i) v[i] = __builtin_nontemporal_load((const f32x4*)(src + (size_t)(r8 + 8 * i) * srcLd + c4));
#pragma unroll
    for (int i = 0; i < 8; ++i) { LAS float* p = scr + (r8 + 8 * i) * 33 + c4; p[0] = v[i][0]; p[1] = v[i][1]; p[2] = v[i][2]; p[3] = v[i][3]; }
    LDS_WAIT(); asm volatile("" ::: "memory");
    const int c = lane & 7;
#pragma unroll
    for (int j = 0; j < 4; ++j) { const int n = (lane >> 3) + 8 * j; const LAS float* s = scr + (8 * c) * 33 + n;
        u32x4 o; o.x = pk2(s[0 * 33], s[1 * 33]); o.y = pk2(s[2 * 33], s[3 * 33]); o.z = pk2(s[4 * 33], s[5 * 33]); o.w = pk2(s[6 * 33], s[7 * 33]);
        *(GAS u32x4*)(dst + (size_t)n * dstLd + 8 * c) = o; }
    LDS_WAIT(); asm volatile("" ::: "memory");
}
constexpr int J_W1 = 2 * 16 * 176, J_W2 = 2 * 44 * 32, J_WIN = 16 * 144, J_WGLU = 8 * 16, J_WBRA = 8 * 32, J_WBRB = 4 * 32, J_WBRC = 4 * 32, J_WOUT = 16 * 32;
constexpr int J_LAYER = J_W1 + J_W2 + J_WIN + J_WGLU + J_WBRA + J_WBRB + J_WBRC + J_WOUT;
constexpr int J_TRANS = J_LAYER;
constexpr int J_MOD = 2 * 16 * 36;
constexpr int J_PE = 256;
constexpr int J_ALL = J_TRANS + J_MOD + J_PE;

__device__ __forceinline__ void p0_trans(KArgP a, int it, LAS float* scr, int lane) {
    const int l = it / J_LAYER; int r = it % J_LAYER;
    bf16_t* wl = (bf16_t*)(a->ws + WS_W + (size_t)l * WL_SZ);
    if (r < J_W1) {
        const int f = r / (16 * 176); r %= 16 * 176; const int kb = r / 176, nb = r % 176, n0 = 32 * nb, tile = n0 >> 8, rr = n0 & 255, half = rr >> 7;
        const int scol = half * DFF + 128 * tile + (rr & 127);
        p0_transpose_item(a->in[I_W1] + ((size_t)(l * 2 + f) * D + 64 * kb) * (2 * DFF) + scol, 2 * DFF, wl + (WL_W1 + f * W1T_SZ) / 2 + (size_t)n0 * D + 64 * kb, D, scr, lane); return; }
    r -= J_W1;
    if (r < J_W2) {
        const int f = r / (44 * 32); r %= 44 * 32; const int kb = r / 32, nb = r % 32;
        p0_transpose_item(a->in[I_W2] + ((size_t)(l * 2 + f) * DFF + 64 * kb) * D + 32 * nb, D, wl + (WL_W2 + f * W2T_SZ) / 2 + (size_t)(32 * nb) * DFF + 64 * kb, DFF, scr, lane); return; }
    r -= J_W2;
    if (r < J_WIN) {
        const int kb = r / 144, nb = r % 144, n0 = 32 * nb; const float* src; int sld;
        if (n0 < 1536) { int scol = n0; if (n0 >= 512 && n0 < 1024) { const int q = n0 - 512, tile = q >> 8, rr = q & 255, half = rr >> 7; scol = 512 + half * 256 + 128 * tile + (rr & 127); }
            src = a->in[I_WIN] + ((size_t)l * D + 64 * kb) * INC + scol; sld = INC; }
        else { src = a->in[I_WGATE] + ((size_t)l * D + 64 * kb) * (3 * D) + (n0 - 1536); sld = 3 * D; }
        p0_transpose_item(src, sld, wl + WL_WIN / 2 + (size_t)n0 * D + 64 * kb, D, scr, lane); return; }
    r -= J_WIN;
    if (r < J_WGLU) { const int kb = r / 16, nb = r % 16;
        p0_transpose_item(a->in[I_WGLU] + ((size_t)l * S5W + 64 * kb) * S5W + 32 * nb, S5W, wl + WL_WGLU / 2 + (size_t)(32 * nb) * S5W + 64 * kb, S5W, scr, lane); return; }
    r -= J_WGLU;
    if (r < J_WBRA) { const int kb = r / 32, nb = r % 32;
        p0_transpose_item(a->in[I_WBRA] + ((size_t)l * S5W + 64 * kb) * D + 32 * nb, D, wl + WL_WBR / 2 + (size_t)(32 * nb) * D + 64 * kb, D, scr, lane); return; }
    r -= J_WBRA;
    if (r < J_WBRB) { const int kb = r / 32, nb = r % 32;
        p0_transpose_item(a->in[I_WBRB] + ((size_t)l * CW + 64 * kb) * D + 32 * nb, D, wl + WL_WBR / 2 + (size_t)(32 * nb) * D + 512 + 64 * kb, D, scr, lane); return; }
    r -= J_WBRB;
    if (r < J_WBRC) { const int kb = r / 32, nb = r % 32;
        p0_transpose_item(a->in[I_WBRC] + ((size_t)l * SGW + 64 * kb) * D + 32 * nb, D, wl + WL_WBR / 2 + (size_t)(32 * nb) * D + 768 + 64 * kb, D, scr, lane); return; }
    r -= J_WBRC;
    { const int kb = r / 32, nb = r % 32;
        p0_transpose_item(a->in[I_WOUT] + ((size_t)l * D + 64 * kb) * D + 32 * nb, D, wl + WL_WOUT / 2 + (size_t)(32 * nb) * D + 64 * kb, D, scr, lane); }
}
__device__ __forceinline__ void p0_mod(KArgP a, int r, LAS float* scr, int lane, const float wgt) {
    const int l = r / (16 * 36); r %= 16 * 36; const int ks = r / 36, nb = r % 36, k0 = 64 * ks, n0 = 256 * nb + 4 * lane;
#pragma unroll
    for (int c = 0; c < 9; ++c) { const float v = c == 0 ? a->in[I_CCTX][k0 + lane] : a->in[I_C][(size_t)(c - 1) * D + k0 + lane]; scr[c * 64 + lane] = fast_silu(v); }
    LDS_WAIT(); asm volatile("" ::: "memory");
    f32x4 acc[9];
#pragma unroll
    for (int c = 0; c < 9; ++c) acc[c] = (f32x4){0.f, 0.f, 0.f, 0.f};
    const float* W = a->in[I_WMOD] + ((size_t)l * D + k0) * (NMOD * D) + n0;
#pragma unroll 16
    for (int k = 0; k < 64; ++k) { const f32x4 w = __builtin_nontemporal_load((const f32x4*)(W + (size_t)k * (NMOD * D)));
#pragma unroll
        for (int c = 0; c < 9; ++c) acc[c] += w * scr[c * 64 + k]; }
    float* mod = (float*)(a->ws + WS_MOD) + (size_t)l * 9 * (NMOD * D) + n0;
    f32x4 bias = (f32x4){0.f, 0.f, 0.f, 0.f};
    if (ks == 0) bias = *(const f32x4*)(a->in[I_BMOD] + (size_t)l * NMOD * D + n0);
#pragma unroll
    for (int c = 0; c < 9; ++c) { const f32x4 v = (acc[c] + bias) * wgt;
#pragma unroll
        for (int e = 0; e < 4; ++e) atomicAdd(mod + (size_t)c * (NMOD * D) + e, v[e]); }
    LDS_WAIT(); asm volatile("" ::: "memory");
}
__device__ __forceinline__ void p0_pe(KArgP a, int r, int lane) {
    const int e = r * 64 + lane, pos = e >> 8, i = e & 255;
    const double omega = 1.0 / pow(10000.0, (double)i / 256.0), ang = (double)pos * omega;
    float* pe = (float*)(a->ws + WS_PE);
    *(f32x2*)(pe + (size_t)e * 2) = (f32x2){(float)sin(ang), (float)cos(ang)};
}
__device__ __forceinline__ void p0_s5(KArgP a, const Frame& F, int l, int g) {
    LAS f32x2* PW = (LAS f32x2*)F.lds; LAS f32x2* BB = PW + 2 * 64 * 17; LAS f32x2* CC = BB + 2 * 64 * 16; LAS float* KFf = (LAS float*)(CC + 2 * 16 * 64); LAS float* KFb = KFf + 4096;
    const int tid = F.tid;
    if (tid < 128) {
        const int dir = tid >> 6, p = tid & 63, ig = (l * 2 + dir) * NG + g, ip = ig * NP + p;
        f32x4 br4[4], bi4[4]; float cr[16], ci[16];
#pragma unroll
        for (int q = 0; q < 4; ++q) { br4[q] = *(const f32x4*)(a->in[I_BRE] + (size_t)ip * GH + 4 * q); bi4[q] = *(const f32x4*)(a->in[I_BIM] + (size_t)ip * GH + 4 * q); }
#pragma unroll
        for (int h = 0; h < 16; ++h) { cr[h] = a->in[I_CRE][((size_t)ig * GH + h) * NP + p]; ci[h] = a->in[I_CIM][((size_t)ig * GH + h) * NP + p]; }
        const double are = a->in[I_ARE][ip], aim = a->in[I_AIM][ip], dt = exp((double)a->in[I_LOGDT][ig]);
        const double mag = exp(are * dt), abr = mag * cos(aim * dt), abi = mag * sin(aim * dt);
        const double den = are * are + aim * aim, nr = abr - 1.0, ni = abi;
        const double qr = (nr * are + ni * aim) / den, qi = (ni * are - nr * aim) / den;
        double pr = 1.0, pi = 0.0;
        for (int d = 0; d <= 16; ++d) { PW[(dir * 64 + p) * 17 + d] = (f32x2){(float)pr, (float)pi}; const double t = pr * abr - pi * abi; pi = pr * abi + pi * abr; pr = t; }
        const f32x2 a16 = PW[(dir * 64 + p) * 17 + 16];
        *(f32x2*)((float*)(a->ws + WS_AT) + ((size_t)(ig) * NP + p) * 2) = a16;
        const float qrf = (float)qr, qif = (float)qi;
#pragma unroll
        for (int h = 0; h < 16; ++h) {
            const float br = br4[h >> 2][h & 3], bi = bi4[h >> 2][h & 3];
            BB[(dir * 64 + p) * 16 + h] = (f32x2){qrf * br - qif * bi, qrf * bi + qif * br};
            CC[(dir * 16 + h) * 64 + p] = (f32x2){cr[h], ci[h]};
        }
    }
    LDS_WAIT(); __syncthreads();
    {
        const int dir = tid >> 8, d = (tid >> 4) & 15, hp = tid & 15;
        float acc[16];
#pragma unroll
        for (int h = 0; h < 16; ++h) acc[h] = 0.f;
        for (int p = 0; p < 64; ++p) {
            const f32x2 w = PW[(dir * 64 + p) * 17 + d], b = BB[(dir * 64 + p) * 16 + hp];
            const float er = w.x * b.x - w.y * b.y, ei = w.x * b.y + w.y * b.x;
#pragma unroll
            for (int h = 0; h < 16; ++h) { const f32x2 c = CC[(dir * 16 + h) * 64 + p]; acc[h] += c.x * er - c.y * ei; }
        }
        LAS float* KFd = dir == 0 ? KFf : KFb;
#pragma unroll
        for (int h = 0; h < 16; ++h) KFd[(d * 16 + h) * 16 + hp] = acc[h];
    }
    LDS_WAIT(); __syncthreads();
    bf16_t* KP = (bf16_t*)(a->ws + WS_KP) + (size_t)(l * NG + g) * 256 * 512;
    for (int e = tid; e < 256 * 64; e += 512) {
        const int n = e >> 6, kc = (e & 63) * 8, i = n >> 4, h = n & 15;
        float v[8];
        if (kc < 256) { const int j = kc >> 4, hp0 = kc & 15, dl = i - j;
            if (dl > 0) {
#pragma unroll
                for (int q = 0; q < 8; ++q) v[q] = KFf[(dl * 16 + h) * 16 + hp0 + q];
            } else if (dl < 0) {
#pragma unroll
                for (int q = 0; q < 8; ++q) v[q] = KFb[(-dl * 16 + h) * 16 + hp0 + q];
            } else { const float dd = a->in[I_S5D][(size_t)l * S5W + g * GH + h];
#pragma unroll
                for (int q = 0; q < 8; ++q) v[q] = KFf[h * 16 + hp0 + q] + KFb[h * 16 + hp0 + q] + ((hp0 + q) == h ? dd : 0.f);
            } }
        else { const int kk = kc - 256, dir = kk >> 7, reim = (kk >> 6) & 1, p0 = kk & 63, ex = dir == 0 ? i + 1 : 16 - i;
#pragma unroll
            for (int q = 0; q < 8; ++q) { const f32x2 c = CC[(dir * 16 + h) * 64 + p0 + q], w = PW[(dir * 64 + p0 + q) * 17 + ex];
                v[q] = reim == 0 ? (c.x * w.x - c.y * w.y) : -(c.x * w.y + c.y * w.x); } }
        u32x4 o; o.x = pk2(v[0], v[1]); o.y = pk2(v[2], v[3]); o.z = pk2(v[4], v[5]); o.w = pk2(v[6], v[7]);
        *(GAS u32x4*)(KP + (size_t)n * 512 + kc) = o;
    }
    bf16_t* PIN = (bf16_t*)(a->ws + WS_PIN) + (size_t)(l * NG + g) * 256 * 256;
    for (int e = tid; e < 256 * 32; e += 512) {
        const int n = e >> 5, kc = (e & 31) * 8, dir = n >> 7, reim = (n >> 6) & 1, p = n & 63, j = kc >> 4, hp0 = kc & 15, ex = dir == 0 ? 15 - j : j;
        const f32x2 w = PW[(dir * 64 + p) * 17 + ex];
        float v[8];
#pragma unroll
        for (int q = 0; q < 8; ++q) { const f32x2 b = BB[(dir * 64 + p) * 16 + hp0 + q]; v[q] = reim == 0 ? (w.x * b.x - w.y * b.y) : (w.x * b.y + w.y * b.x); }
        u32x4 o; o.x = pk2(v[0], v[1]); o.y = pk2(v[2], v[3]); o.z = pk2(v[4], v[5]); o.w = pk2(v[6], v[7]);
        *(GAS u32x4*)(PIN + (size_t)n * 256 + kc) = o;
    }
    LDS_WAIT(); __syncthreads();
}
__device__ __forceinline__ void p0_prologue(KArgP a, const Frame& F, const bool rep = false) {
    const int parts = rep ? REP0_PARTS : 15;
    if ((parts & 1) && F.vcu < 2 * NG) p0_s5(a, F, F.vcu / NG, F.vcu % NG);
    LAS float* scr = (LAS float*)(F.lds + F.wave * 16384);
    const int gw = F.vcu * NWAVES + F.wave, NGW = F.G * NWAVES;
    for (int it = gw; it < J_ALL; it += NGW) {
        if (it < J_MOD) { if (parts & 2) p0_mod(a, it, scr, F.lane, rep ? 0.f : 1.f); }
        else if (it < J_MOD + J_PE) { if (parts & 4) p0_pe(a, it - J_MOD, F.lane); }
        else { if (parts & 8) p0_trans(a, it - J_MOD - J_PE, scr, F.lane); }
    }
}

__device__ __forceinline__ void shw_tasks(KArgP a, const int l, const int gw, const int NGW, const int lane) {
    constexpr int T0 = 2 * DFF / 16, T1 = NIN / 16, TL = 2 * T0 + T1;
    const float* mod0 = (const float*)(a->ws + WS_MOD);
    const int cnd = lane & 15, kq = lane >> 4;
    for (int task = gw; task < TL; task += NGW) {
        int t = task; int sub, nb;
        if (t < T0) { sub = 0; nb = t; } else if (t < T0 + T1) { sub = 1; nb = t - T0; } else { sub = 2; nb = t - T0 - T1; }
        const char* wl = (const char*)(a->ws + WS_W + (size_t)l * WL_SZ);
        const bf16_t* Wt = (const bf16_t*)(sub == 1 ? wl + WL_WIN : wl + WL_W1 + (sub == 2 ? W1T_SZ : 0));
        const float* shp = mod0 + (size_t)l * 9 * (NMOD * D) + (size_t)(cnd < 9 ? cnd : 0) * (NMOD * D) + (3 * sub) * D + 8 * kq;
        const bf16_t* wp = Wt + (size_t)(16 * nb + cnd) * D + 8 * kq;
        f32x4 acc = (f32x4){0.f, 0.f, 0.f, 0.f};
#pragma unroll 8
        for (int kk = 0; kk < 32; ++kk) {
            const f32x4 s0 = *(const f32x4*)(shp + 32 * kk), s1 = *(const f32x4*)(shp + 32 * kk + 4);
            u32x4 au; au.x = pk2(s0[0], s0[1]); au.y = pk2(s0[2], s0[3]); au.z = pk2(s1[0], s1[1]); au.w = pk2(s1[2], s1[3]);
            if (cnd >= 9) au = (u32x4){0u, 0u, 0u, 0u};
            const bf16x8 bw = *(const bf16x8*)(wp + 32 * kk);
            acc = __builtin_amdgcn_mfma_f32_16x16x32_bf16(__builtin_bit_cast(bf16x8, au), bw, acc, 0, 0, 0);
        }
        float* out = (float*)(a->ws + WS_SHW) + (size_t)(3 * l + sub) * 9 * SHW_LD + 16 * nb + cnd;
#pragma unroll
        for (int r = 0; r < 4; ++r) { const int c2 = 4 * kq + r; if (c2 < 9) out[(size_t)c2 * SHW_LD] = acc[r]; }
    }
}
__device__ __forceinline__ void deferred_l1(KArgP a, const Frame& F, const int part, const int wi, const int nw) {
    LAS float* scr = (LAS float*)(F.lds + F.wave * 16384);
    if (part == 0) { for (int i = wi; i < J_W1 + J_WIN; i += nw) p0_trans(a, J_LAYER + (i < J_W1 ? i : i + J_W2), scr, F.lane); }
    else { for (int i = wi; i < J_LAYER - J_W1 - J_WIN; i += nw) p0_trans(a, J_LAYER + (i < J_W2 ? J_W1 + i : i + J_W1 + J_WIN), scr, F.lane);
           shw_tasks(a, 1, wi, nw, F.lane); }
}
__device__ __forceinline__ void embed_phase(KArgP a, const Frame& F) {
    const int gw = F.vcu * NWAVES + F.wave, NGW = F.G * NWAVES, lane = F.lane;
    bf16_t* X = (bf16_t*)a->out; bf16_t* H = (bf16_t*)(a->ws + WS_H);
    const float* gam = a->in[I_NORMG];
    const float* mod0 = (const float*)(a->ws + WS_MOD);
    const float* pe = (const float*)(a->ws + WS_PE);
    float* ssq = (float*)(a->ws + WS_SSQ);
    for (int row = gw; row < M; row += NGW) {
        f32x4 v[4]; float s = 0.f;
        if (row < MCTX) {
#pragma unroll
            for (int j = 0; j < 4; ++j) v[j] = *(const f32x4*)(a->in[I_XP] + (size_t)row * D + 4 * lane + 256 * j);
        } else {
            const int t = (row - MCTX) & (SMPL - 1), rr = t >> 6, cc = t & 63;
#pragma unroll
            for (int j = 0; j < 4; ++j) { v[j] = *(const f32x4*)(a->in[I_XS] + (size_t)(row - MCTX) * D + 4 * lane + 256 * j);
                const int pos = j < 2 ? rr : cc;
#pragma unroll
                for (int e = 0; e < 4; ++e) v[j][e] += pe[((size_t)pos * 256 + 4 * lane + e) * 2 + (j & 1)]; }
        }
#pragma unroll
        for (int j = 0; j < 4; ++j) { u32x2 xw; xw.x = pk2(v[j][0], v[j][1]); xw.y = pk2(v[j][2], v[j][3]); *(u32x2*)(X + (size_t)row * D + 4 * lane + 256 * j) = xw; s += (v[j][0] * v[j][0] + v[j][1] * v[j][1]) + (v[j][2] * v[j][2] + v[j][3] * v[j][3]); }
        s = wave_sum(s);
        if (lane == 0) ssq[row] = s;
        const float* md = mod0 + (size_t)cond_of_row(row) * (NMOD * D);
#pragma unroll
        for (int j = 0; j < 4; ++j) { const int d = 4 * lane + 256 * j;
            const f32x4 o = v[j] * *(const f32x4*)(gam + d) * (*(const f32x4*)(md + D + d) + 1.f);
            u32x2 w; w.x = pk2(o[0], o[1]); w.y = pk2(o[2], o[3]);
            *(u32x2*)(H + (size_t)row * D + d) = w; }
    }
    shw_tasks(a, 0, gw, NGW, lane);
}
template <class Sched> __device__ __forceinline__ pg8::Stash stash_units(const Sched& S, LAS unsigned char* lds, const float* ssq, const float* shw, const float* bgate  , const int wv) {
    LAS float* sr = (LAS float*)(lds + STASH_OFF); LAS float* ss = sr + STASH_UNITS * 256;
    int tid = tid_of(wv); asm volatile("" : "+v"(tid));
    for (int i = 0; i < STASH_UNITS; ++i) { pg8::Unit u; if (!S.next(i, u)) break;
        if (tid < 256) sr[i * 256 + tid] = rsqrtf(ssq[u.pm * 256 + tid] * (1.f / D) + EPS);
        else { const int c = u.pn * 256 + (tid - 256); float v = shw[(size_t)cond_of_tile(u.pm) * SHW_LD + c]; if (bgate && c >= INC) v += bgate[c - INC]; ss[i * 256 + tid - 256] = v; } }
    LDS_WAIT(); __syncthreads();
    return pg8::Stash{sr, ss};
}
__device__ __forceinline__ void final_phase(KArgP a, const Frame& F) {
    const int gw = F.vcu * NWAVES + F.wave, NGW = F.G * NWAVES, lane = F.lane;
    float* X = a->out; const float* gam = a->in[I_FINALG];
    for (int row = gw; row < M; row += NGW) {
        f32x4 v[4]; float s = 0.f;
#pragma unroll
        for (int j = 0; j < 4; ++j) { v[j] = *(const f32x4*)(X + (size_t)row * D + 4 * lane + 256 * j); s += (v[j][0] * v[j][0] + v[j][1] * v[j][1]) + (v[j][2] * v[j][2] + v[j][3] * v[j][3]); }
        const float r = rsqrtf(wave_sum(s) * (1.f / D) + EPS);
#pragma unroll
        for (int j = 0; j < 4; ++j) { const int d = 4 * lane + 256 * j; *(f32x4*)(X + (size_t)row * D + d) = v[j] * r * *(const f32x4*)(gam + d); }
    }
}

constexpr int SG_V_OFF = 32768;
__device__ __forceinline__ void conv_item(KArgP a, const Frame& F, int l, int item) {
    const int tok0 = item * 64;
    int s0, s1; if (tok0 < MCTX) { s0 = tok0 & ~(CTXL - 1); s1 = s0 + CTXL; } else { s0 = MCTX + ((tok0 - MCTX) & ~(SMPL - 1)); s1 = s0 + SMPL; }
    const bf16_t* CG = (const bf16_t*)(a->ws + WS_CG);
    LAS unsigned char* Gt = F.lds;
    LAS float* Wt = (LAS float*)(F.lds + 49152);
    const float* cw = a->in[I_CONVW] + (size_t)l * CK * CW;
    u32x4 gl[6]; f32x4 wv[4];
#pragma unroll
    for (int i = 0; i < 6; ++i) { const int q = F.tid + 512 * i, row = q >> 5, cc = q & 31, tok = tok0 - 15 + row;
        gl[i] = (u32x4){0u, 0u, 0u, 0u}; if (q < 94 * 32 && tok >= s0 && tok < s1) gl[i] = *(const u32x4*)(CG + (size_t)tok * CW + cc * 8); }
#pragma unroll
    for (int i = 0; i < 4; ++i) { const int q = F.tid + 512 * i; wv[i] = (f32x4){0.f, 0.f, 0.f, 0.f}; if (q < CK * CW / 4) wv[i] = *(const f32x4*)(cw + 4 * q); }
#pragma unroll
    for (int i = 0; i < 6; ++i) { const int q = F.tid + 512 * i, row = q >> 5, cc = q & 31; if (q < 94 * 32) *(LAS u32x4*)(Gt + row * 512 + cc * 16) = gl[i]; }
#pragma unroll
    for (int i = 0; i < 4; ++i) { const int q = F.tid + 512 * i; if (q < CK * CW / 4) *(LAS f32x4*)(Wt + 4 * q) = wv[i]; }
    const int lane = F.lane, c0 = 4 * lane;
    const f32x4 bias = *(const f32x4*)(a->in[I_CONVB] + (size_t)l * CW + c0), lg = *(const f32x4*)(a->in[I_CLNG] + (size_t)l * CW + c0), lb = *(const f32x4*)(a->in[I_CLNB] + (size_t)l * CW + c0);
    LDS_WAIT(); __syncthreads();
    bf16_t* YC = (bf16_t*)(a->ws + WS_H);
    const int tl0 = 8 * F.wave;
    f32x4 acc[8];
#pragma unroll
    for (int t = 0; t < 8; ++t) acc[t] = bias;
#pragma unroll 1
    for (int k = 0; k < CK; ++k) { const f32x4 w = *(const LAS f32x4*)(Wt + k * CW + c0);
#pragma unroll
        for (int t = 0; t < 8; ++t) { const u32x2 gv = *(const LAS u32x2*)(Gt + (tl0 + t + k) * 512 + lane * 8);
            acc[t][0] += w[0] * bflo(gv.x); acc[t][1] += w[1] * bfhi(gv.x); acc[t][2] += w[2] * bflo(gv.y); acc[t][3] += w[3] * bfhi(gv.y); } }
    float mu[8], q2[8];
#pragma unroll
    for (int t = 0; t < 8; ++t) mu[t] = (acc[t][0] + acc[t][1]) + (acc[t][2] + acc[t][3]);
#pragma unroll
    for (int o = 1; o < 64; o <<= 1)
#pragma unroll
        for (int t = 0; t < 8; ++t) mu[t] += __shfl_xor(mu[t], o);
#pragma unroll
    for (int t = 0; t < 8; ++t) { mu[t] *= (1.f / CW); acc[t] = acc[t] - mu[t]; q2[t] = (acc[t][0] * acc[t][0] + acc[t][1] * acc[t][1]) + (acc[t][2] * acc[t][2] + acc[t][3] * acc[t][3]); }
#pragma unroll
    for (int o = 1; o < 64; o <<= 1)
#pragma unroll
        for (int t = 0; t < 8; ++t) q2[t] += __shfl_xor(q2[t], o);
#pragma unroll
    for (int t = 0; t < 8; ++t) {
        const float rstd = rsqrtf(q2[t] * (1.f / CW) + EPS);
        const f32x4 y = acc[t] * rstd * lg + lb;
        u32x2 w; w.x = pk2(fast_silu(y[0]), fast_silu(y[1])); w.y = pk2(fast_silu(y[2]), fast_silu(y[3]));
        *(u32x2*)(YC + (size_t)(tok0 + tl0 + t) * D + 512 + c0) = w;
    }
    LDS_WAIT(); __syncthreads();
}
__device__ __forceinline__ void sg_wave_item(KArgP a, const Frame& F, int l, int witem) {
    const int cb = witem & 1, h = (witem >> 1) & 3, cidx = witem >> 3, tb = cidx * SGC, lane = F.lane, c0 = 64 * h + 32 * cb;
    const bf16_t* SU = (const bf16_t*)(a->ws + WS_SU); const bf16_t* SV = (const bf16_t*)(a->ws + WS_SV); const float* ST = (const float*)(a->ws + WS_SVST);
    LAS bf16_t* Vw = (LAS bf16_t*)(F.lds + SG_V_OFF + F.wave * 8192);
    {
        const int c8 = (lane & 3) * 8, rb = lane >> 2;
        u32x4 raw[8]; f32x4 t0[8], t1[8];
#pragma unroll
        for (int i = 0; i < 8; ++i) { const size_t tok = tb + rb + 16 * i; raw[i] = *(const u32x4*)(SV + tok * SGW + c0 + c8); t0[i] = *(const f32x4*)(ST + tok * 8); t1[i] = *(const f32x4*)(ST + tok * 8 + 4); }
        const float* gp = a->in[I_SGLNG] + (size_t)l * SGW + c0 + c8; const float* bp = a->in[I_SGLNB] + (size_t)l * SGW + c0 + c8;
        const f32x4 lg0 = *(const f32x4*)gp, lg1 = *(const f32x4*)(gp + 4), lb0 = *(const f32x4*)bp, lb1 = *(const f32x4*)(bp + 4);
#pragma unroll
        for (int i = 0; i < 8; ++i) {
            const float mu = ((t0[i][0] + t0[i][2]) + (t1[i][0] + t1[i][2])) * (1.f / SGW), ex2 = ((t0[i][1] + t0[i][3]) + (t1[i][1] + t1[i][3])) * (1.f / SGW);
            const float rstd = rsqrtf(fmaxf(ex2 - mu * mu, 0.f) + EPS);
            const f32x4 v0 = (f32x4){bflo(raw[i].x), bfhi(raw[i].x), bflo(raw[i].y), bfhi(raw[i].y)}, v1 = (f32x4){bflo(raw[i].z), bfhi(raw[i].z), bflo(raw[i].w), bfhi(raw[i].w)};
            const f32x4 y0 = (v0 - mu) * rstd * lg0 + lb0, y1 = (v1 - mu) * rstd * lg1 + lb1;
            u32x4 o; o.x = pk2(y0[0], y0[1]); o.y = pk2(y0[2], y0[3]); o.z = pk2(y1[0], y1[1]); o.w = pk2(y1[2], y1[3]);
            *(LAS u32x4*)(Vw + (rb + 16 * i) * 32 + c8) = o;
        }
    }
    LDS_WAIT(); asm volatile("" ::: "memory");
    const int h2 = lane >> 5, ci = lane & 31;
    u32x4 av[8];
#pragma unroll
    for (int ks = 0; ks < 8; ++ks) { const LAS bf16_t* vp = Vw + (16 * ks + 8 * h2) * 32 + ci;
        av[ks].x = (unsigned)vp[0] | ((unsigned)vp[32] << 16); av[ks].y = (unsigned)vp[64] | ((unsigned)vp[96] << 16); av[ks].z = (unsigned)vp[128] | ((unsigned)vp[160] << 16); av[ks].w = (unsigned)vp[192] | ((unsigned)vp[224] << 16); }
    bf16_t* YC = (bf16_t*)(a->ws + WS_H);
#pragma unroll 1
    for (int qb = 0; qb < 4; ++qb) {
        const int q = 32 * qb + ci; const size_t tok = tb + q;
        const float* Wh = a->in[I_SGW] + ((size_t)(l * SGH + h) * SGC + q) * SGC + 8 * h2;
        f32x4 w0[8], w1[8];
#pragma unroll
        for (int ks = 0; ks < 8; ++ks) { w0[ks] = *(const f32x4*)(Wh + 16 * ks); w1[ks] = *(const f32x4*)(Wh + 16 * ks + 4); }
        u32x2 suv[4];
#pragma unroll
        for (int jg = 0; jg < 4; ++jg) suv[jg] = *(const u32x2*)(SU + tok * SGW + c0 + 8 * jg + 4 * h2);
        const float sbv = a->in[I_SGB][(size_t)(l * SGH + h) * SGC + q];
        f32x16 acc;
#pragma unroll
        for (int i = 0; i < 16; ++i) acc[i] = 0.f;
#pragma unroll
        for (int ks = 0; ks < 8; ++ks) {
            u32x4 bu; bu.x = pk2(w0[ks][0], w0[ks][1]); bu.y = pk2(w0[ks][2], w0[ks][3]); bu.z = pk2(w1[ks][0], w1[ks][1]); bu.w = pk2(w1[ks][2], w1[ks][3]);
            acc = __builtin_amdgcn_mfma_f32_32x32x16_bf16(__builtin_bit_cast(bf16x8, av[ks]), __builtin_bit_cast(bf16x8, bu), acc, 0, 0, 0);
        }
#pragma unroll
        for (int jg = 0; jg < 4; ++jg) {
            const float u0 = bflo(suv[jg].x), u1 = bfhi(suv[jg].x), u2 = bflo(suv[jg].y), u3 = bfhi(suv[jg].y);
            u32x2 o; o.x = pk2(u0 * (acc[4 * jg] + sbv), u1 * (acc[4 * jg + 1] + sbv)); o.y = pk2(u2 * (acc[4 * jg + 2] + sbv), u3 * (acc[4 * jg + 3] + sbv));
            *(u32x2*)(YC + tok * D + 768 + c0 + 8 * jg + 4 * h2) = o;
        }
    }
    LDS_WAIT(); asm volatile("" ::: "memory");
}

constexpr int PH_PER_LAYER = 10, PH_L0 = 2, N_PHASES = PH_L0 + DEPTH * PH_PER_LAYER + 1;

__device__ __forceinline__ Frame make_frame(LAS unsigned char* lds, const int wv) {
    Frame F;
    F.lds = lds; F.MISC = (volatile LAS unsigned*)(lds + MISC_OFF);
    { int t = tid_of(wv); asm volatile("" : "+v"(t)); F.tid = t; }
    F.lane = F.tid & 63; F.wave = wv;
    F.G = gridDim.x; { const int bx = blockIdx.x; F.vcu = (F.G % 8 == 0) ? (bx % 8) * (F.G / 8) + bx / 8 : bx; }
    return F;
}

__device__ __forceinline__ void layer_phase(KArgP args, const int l, const int k, LAS unsigned char* ring, const bool rep, const int wv) {
    unsigned char* ws = args->ws;
    int G = gridDim.x, cid = (int)blockIdx.x; asm volatile("" : "+s"(G), "+s"(cid));
    const char* wl = (const char*)(ws + WS_W + (size_t)l * WL_SZ);
    const float* mod0 = (const float*)(ws + WS_MOD);
    const float* modl = mod0 + (size_t)l * 9 * (NMOD * D);
    float* ssq0 = (float*)(ws + WS_SSQ);
    const float* shw0 = (const float*)(ws + WS_SHW);
    if (k == 0 || k == 8) {
        const int f = k == 0 ? 0 : 1, site = 3 * l + 2 * f;
        pg8::PlainSched S; S.T.init(M / 256, 2 * DFF / 256, G, cid); S.A = (const char*)(ws + WS_H); S.Bt = wl + WL_W1 + f * W1T_SZ;
        S.aStride = 256L * D * 2; S.bStride = 256L * D * 2; S.bgStride = 0; S.bgShift = 0; S.nt = D / 64;
        const pg8::Stash st = stash_units(S, ring, ssq0 + (size_t)site * M, shw0 + (size_t)site * 9 * SHW_LD, nullptr, wv);
        pg8::EpiSwiGLU E{(bf16_t*)(ws + WS_HID), st};
        pg8::gemm_phase<pg8::EpiSwiGLU, pg8::PlainSched, true, true>(ring, D, D, S, E, wv);
    } else if (k == 1 || k == 9 || k == 7) {
        const bool is_out = k == 7; const int f = k == 1 ? 0 : 1;
        const int kk = is_out ? D : DFF;
        pg8::PlainSched S; S.T.init(M / 256, D / 256, G, cid); S.A = (const char*)(ws + (is_out ? WS_MG : WS_HID)); S.Bt = is_out ? wl + WL_WOUT : wl + WL_W2 + f * W2T_SZ;
        S.aStride = 256L * kk * 2; S.bStride = 256L * kk * 2; S.bgStride = 0; S.bgShift = 0; S.nt = kk / 64;
        const int nl = k == 9 ? l + 1 : l, nsub = k == 1 ? 1 : (k == 7 ? 2 : 0);
        const bool has_next = !rep && nl < DEPTH;
        bf16_t* xb0 = (bf16_t*)args->out; bf16_t* xb1 = (bf16_t*)(ws + WS_GATES);
        const bool last_l = l == DEPTH - 1;
        const bf16_t* xin = (last_l && k == 9) ? xb1 : xb0; bf16_t* xout = (last_l && k == 7 && !rep) ? xb1 : xb0; float* xf = (last_l && k == 9 && !rep) ? args->out : nullptr;
        if (rep) xout = (bf16_t*)xin;
        pg8::EpiResid E{xin, xout, xf, modl, is_out ? 1 : (f == 0 ? 0 : 2), rep ? 0.f : (is_out ? 1.0f : 0.5f),
                        has_next ? (bf16_t*)(ws + WS_H) : nullptr, args->in[I_NORMG] + (size_t)((has_next ? nl : 0) * 3 + nsub) * D, mod0 + (size_t)(has_next ? nl : 0) * 9 * (NMOD * D), nsub,
                        ssq0 + (size_t)(3 * (has_next ? nl : 0) + nsub) * M};
        pg8::gemm_phase<pg8::EpiResid, pg8::PlainSched, true, true>(ring, kk, kk, S, E, wv);
    } else if (k == 2) {
        const int site = 3 * l + 1;
        pg8::PlainSched S; S.T.init(M / 256, NIN / 256, G, cid); S.A = (const char*)(ws + WS_H); S.Bt = wl + WL_WIN;
        S.aStride = 256L * D * 2; S.bStride = 256L * D * 2; S.bgStride = 0; S.bgShift = 0; S.nt = D / 64;
        const pg8::Stash st = stash_units(S, ring, ssq0 + (size_t)site * M, shw0 + (size_t)site * 9 * SHW_LD, args->in[I_BGATE] + (size_t)l * 3 * D, wv);
        pg8::EpiMixIn E{(bf16_t*)(ws + WS_YCAT), (bf16_t*)(ws + WS_CG), (bf16_t*)(ws + WS_SU), (bf16_t*)(ws + WS_SV), (bf16_t*)(ws + WS_GATES), (float*)(ws + WS_SVST), st};
        pg8::gemm_phase<pg8::EpiMixIn, pg8::PlainSched, true, true>(ring, D, D, S, E, wv);
    } else if (k == 3) {
        pg8::PlainSched S; S.T.init(NG * YR / 256, 1, G, cid); S.A = (const char*)(ws + WS_YCAT); S.Bt = (const char*)(ws + WS_PIN) + (size_t)l * NG * 256 * 256 * 2;
        S.aStride = 256L * 512 * 2; S.bStride = 0; S.bgStride = 256L * 256 * 2; S.bgShift = 2; S.nt = 4;
        pg8::EpiS5X E{(bf16_t*)(ws + WS_YCAT), (const float*)(ws + WS_AT) + (size_t)l * 2 * NG * NP * 2, args->in[I_STATE], args->out + (size_t)M * D, l};
        const int parts = rep ? REP5_PARTS : 7;
        if (parts & 1) pg8::gemm_phase<pg8::EpiS5X, pg8::PlainSched, false, true>(ring, 512, 256, S, E, wv);
        const int nx = NG * YR / 256;
        if (cid >= nx) {
            const Frame F = make_frame(ring, wv);
            const int wi = (cid - nx) * NWAVES + F.wave, nw = (G - nx) * NWAVES;
            if (parts & 4) for (int it = wi; it < (M / SGC) * SGH * 2; it += nw) sg_wave_item(args, F, l, it);
            __syncthreads();
            if (parts & 2) for (int it = cid - nx; it < M / 64; it += G - nx) conv_item(args, F, l, it);
        }
    } else if (k == 4) {
        pg8::PlainSched S; S.T.init(NG * YR / 256, 1, G, cid); S.A = (const char*)(ws + WS_YCAT); S.Bt = (const char*)(ws + WS_KP) + (size_t)l * NG * 256 * 512 * 2;
        S.aStride = 256L * 512 * 2; S.bStride = 0; S.bgStride = 256L * 512 * 2; S.bgShift = 2; S.nt = 8;
        pg8::EpiS5Y E{(bf16_t*)(ws + WS_YA)};
        pg8::gemm_phase<pg8::EpiS5Y, pg8::PlainSched, true, true>(ring, 512, 512, S, E, wv);
        if (l == 0 && cid >= NG * YR / 256) { const Frame F = make_frame(ring, wv); deferred_l1(args, F, 0, (cid - NG * YR / 256) * NWAVES + F.wave, (G - NG * YR / 256) * NWAVES); }
    } else if (k == 5) {
        pg8::PlainSched S; S.T.init(M / 256, S5W / 256, G, cid); S.A = (const char*)(ws + WS_YA); S.Bt = wl + WL_WGLU;
        S.aStride = 256L * S5W * 2; S.bStride = 256L * S5W * 2; S.bgStride = 0; S.bgShift = 0; S.nt = S5W / 64;
        pg8::EpiGlu E{(const bf16_t*)(ws + WS_YA), (bf16_t*)(ws + WS_H)};
        pg8::gemm_phase<pg8::EpiGlu, pg8::PlainSched, true, true>(ring, S5W, S5W, S, E, wv);
        if (l == 0 && cid >= (M / 256) * (S5W / 256)) { const Frame F = make_frame(ring, wv); deferred_l1(args, F, 1, (cid - (M / 256) * (S5W / 256)) * NWAVES + F.wave, (G - (M / 256) * (S5W / 256)) * NWAVES); }
    } else if (k == 6) {
        pg8::Seg3Sched S; S.T.init(M / 256, D / 256, G, cid); S.A = (const char*)(ws + WS_H); S.Bt = wl + WL_WBR; S.aStride = 256L * D * 2; S.bStride = 256L * D * 2;
        pg8::EpiBranch E{(const bf16_t*)(ws + WS_GATES), (bf16_t*)(ws + WS_MG)};
        pg8::gemm_phase<pg8::EpiBranch, pg8::Seg3Sched, true, true>(ring, D, D, S, E, wv);
    }
}

__global__ void __launch_bounds__(NWAVES * 64, 2) mk_fwd(Args args_by_value) {
    extern __shared__ __attribute__((aligned(16))) unsigned char lds_raw[];
    LAS unsigned char* lds = (LAS unsigned char*)lds_raw;
    KArgP args = (KArgP)__builtin_amdgcn_kernarg_segment_ptr();
    const int wv = __builtin_amdgcn_readfirstlane((int)threadIdx.x >> 6);
    {
        const int t0 = tid_of(wv);
        for (int u = t0; u < (LDS_BYTES - LDSCTL_OFF) / 4; u += NWAVES * 64) ((LAS unsigned*)(lds + LDSCTL_OFF))[u] = 0u;
        __syncthreads();
    }
    XcdBarrier bar; bar.bar = (unsigned*)(args->ws + WS_CTL) + CW_BAR; bar.x = 0; bar.st = nullptr;
#if !MK_PER_PHASE
    bar = xcd_barrier_post((unsigned*)(args->ws + WS_CTL) + CW_BAR, (volatile LAS unsigned*)(lds + MISC_OFF) + 8, wv);
#define GRID_BAR() do { xcd_barrier(bar, wv); if (REP_BAR) xcd_barrier(bar, wv); } while (0)
#else
#define GRID_BAR() do { } while (0)
#endif
    const int lo = args->ph_lo, hi = args->ph_hi;
    if (lo <= 0 && 0 < hi) {
        asm volatile("" : "+s"(args));
        p0_prologue(args, make_frame(lds, wv));
        if (1 < hi) GRID_BAR();
        if ((REP_MASK >> 13) & 1) { p0_prologue(args, make_frame(lds, wv), true); GRID_BAR(); }
    }
    if (lo <= 1 && 1 < hi) {
        asm volatile("" : "+s"(args));
        embed_phase(args, make_frame(lds, wv));
        if (2 < hi) GRID_BAR();
        if ((REP_MASK >> 14) & 1) { embed_phase(args, make_frame(lds, wv)); GRID_BAR(); }
    }
    for (int ph = (lo > PH_L0 ? lo : PH_L0); ph < (hi < N_PHASES - 1 ? hi : N_PHASES - 1); ++ph) {
        const int l = (ph - PH_L0) / PH_PER_LAYER, k = (ph - PH_L0) - l * PH_PER_LAYER;
        asm volatile("" : "+s"(args));
        layer_phase(args, l, k, lds, false, wv);
        if (ph + 1 < hi) GRID_BAR();
        if ((REP_MASK >> k) & 1) { asm volatile("" : "+s"(args)); layer_phase(args, l, k, lds, true, wv); GRID_BAR(); }
    }
    if (lo <= N_PHASES - 1 && N_PHASES - 1 < hi) {
        asm volatile("" : "+s"(args));
        final_phase(args, make_frame(lds, wv));
    }
#undef GRID_BAR
}

extern "C" void kernel_launch(void* const* d_in, const int* in_sizes, int n_in, void* d_out, int out_size, void* d_ws, size_t ws_size, hipStream_t stream) {
    static int grid = 0;
    if (grid == 0) {
        if (n_in != 35 || ws_size < WS_END) { fprintf(stderr, "kernel_launch: unexpected n_in %d or ws_size %zu (< %zu)\n", n_in, ws_size, (size_t)WS_END); grid = -1; return; }
        int dev = 0, cus = 0, per_cu = 0;
        if (hipGetDevice(&dev) != hipSuccess || hipDeviceGetAttribute(&cus, hipDeviceAttributeMultiprocessorCount, dev) != hipSuccess) { grid = -1; return; }
        if (hipFuncSetAttribute((const void*)mk_fwd, hipFuncAttributeMaxDynamicSharedMemorySize, LDS_BYTES) != hipSuccess) { fprintf(stderr, "kernel_launch: hipFuncSetAttribute failed\n"); grid = -1; return; }
        if (hipOccupancyMaxActiveBlocksPerMultiprocessor(&per_cu, (const void*)mk_fwd, NWAVES * 64, LDS_BYTES) != hipSuccess || per_cu < 1)
            fprintf(stderr, "kernel_launch: occupancy query reports %d workgroups per CU\n", per_cu);
        (void)hipGetLastError();
        grid = cus;
        if (grid != 256) fprintf(stderr, "kernel_launch: %d CUs (expected 256)\n", grid);
    }
    if (grid < 0) return;
    (void)hipMemsetAsync((char*)d_ws + WS_CTL, 0, CTL_ZERO_BYTES, stream);
    Args a{};
    for (int i = 0; i < 35; ++i) a.in[i] = (const float*)d_in[i];
    a.out = (float*)d_out; a.ws = (unsigned char*)d_ws;
#if MK_PER_PHASE
    for (int ph = 0; ph < N_PHASES; ++ph) { a.ph_lo = ph; a.ph_hi = ph + 1; hipLaunchKernelGGL(mk_fwd, dim3(grid), dim3(NWAVES * 64), LDS_BYTES, stream, a); }
#else
    a.ph_lo = 0; a.ph_hi = N_PHASES;
    hipLaunchKernelGGL(mk_fwd, dim3(grid), dim3(NWAVES * 64), LDS_BYTES, stream, a);
#endif
}
```
